# Optimizing an MI355X kernel written in HIP

```python
import math
import jax
import jax.numpy as jnp
from jax import lax
import numpy as np

D_MODEL = 1024
BATCH = 2
SEQ = 8192
DEPTH = 1

GRID_W = 64
D_MIX = 1024
EPS = 1e-6

HG_HEADS = 4
HG_DK = 128
HG_DV = 128
HG_KW = HG_HEADS * HG_DK
HG_VW = HG_HEADS * HG_DV
CHUNK = 64

ATT_HEADS = 8
ATT_KV_HEADS = 2
ATT_DH = 64
ATT_GROUP = ATT_HEADS // ATT_KV_HEADS
ATT_QW = ATT_HEADS * ATT_DH
ATT_KVW = ATT_KV_HEADS * ATT_DH
ROPE_THETA = 10000.0
Q_BLOCK = 128

D_IN = 2 * HG_KW + HG_KW + 2 * HG_VW + ATT_QW + 2 * ATT_KVW

D_FF = -(-8 * D_MODEL // (3 * 256)) * 256

kernel_name = "hybrid_hgrn2_axial_gqa_encoder"


def _rmsnorm(x, w):
    xf = x.astype(jnp.float32)
    y = xf * lax.rsqrt(jnp.mean(xf * xf, axis=-1, keepdims=True) + EPS)
    return (y * w.astype(jnp.float32)).astype(x.dtype)


def _gla_chunk_scan(q, k, v, log_f):
    B, L, H, DK = q.shape
    DV = v.shape[-1]
    n = L // CHUNK

    def to_chunks(a):
        return a.reshape(B, n, CHUNK, H, a.shape[-1]).transpose(1, 0, 3, 2, 4)

    qc, kc, vc, gc = to_chunks(q), to_chunks(k), to_chunks(v), to_chunks(log_f)
    b = jnp.cumsum(gc, axis=3)
    b_ref = b[:, :, :, CHUNK // 2 - 1:CHUNK // 2, :]
    b_last = b[:, :, :, -1:, :]
    q_in = qc * jnp.exp(b - b_ref)
    k_in = kc * jnp.exp(b_ref - b)
    scores = jnp.einsum('nbhtk,nbhsk->nbhts', q_in, k_in)
    causal_in_scan = jnp.tril(jnp.ones((CHUNK, CHUNK), dtype=bool))
    scores = jnp.where(causal_in_scan, scores, 0.0)
    o_intra = jnp.einsum('nbhts,nbhsv->nbhtv', scores, vc)
    contrib = jnp.einsum('nbhsk,nbhsv->nbhkv', kc * jnp.exp(b_last - b), vc).astype(jnp.float32)
    decay = jnp.exp(b_last[:, :, :, 0, :]).astype(jnp.float32)

    def step(S, inp):
        d, c = inp
        return d[..., None] * S + c, S

    S0 = jnp.zeros((B, H, DK, DV), jnp.float32)
    _, S_prev = lax.scan(step, S0, (decay, contrib))
    o_inter = jnp.einsum('nbhtk,nbhkv->nbhtv', qc * jnp.exp(b), S_prev)
    o = (o_intra + o_inter).transpose(1, 0, 3, 2, 4).reshape(B, L, H, DV)
    return o.astype(v.dtype)


def _hgrn2_group(u_q, u_ff, u_fb, u_i, u_g, lb_fwd, lb_bwd, norm_w):
    B, L, _ = u_q.shape
    q = jax.nn.silu(u_q).reshape(B, L, HG_HEADS, HG_DK)
    i = u_i.reshape(B, L, HG_HEADS, HG_DV)

    def gates(z, lb):
        zf = z.astype(jnp.float32)
        f = lb + (1.0 - lb) * jax.nn.sigmoid(zf)
        k = (1.0 - lb) * jax.nn.sigmoid(-zf)
        return (jnp.log(f).reshape(B, L, HG_HEADS, HG_DK),
                k.reshape(B, L, HG_HEADS, HG_DK).astype(z.dtype))

    logf_f, k_f = gates(u_ff, lb_fwd)
    logf_b, k_b = gates(u_fb, lb_bwd)
    o_fwd = _gla_chunk_scan(q, k_f, i, logf_f)
    flip = lambda a: jnp.flip(a, axis=1)
    o_bwd = flip(_gla_chunk_scan(flip(q), flip(k_b), flip(i), flip(logf_b)))
    o = _rmsnorm(o_fwd + o_bwd, norm_w)
    o = o * jax.nn.silu(u_g.reshape(B, L, HG_HEADS, HG_DV))
    return o.reshape(B, L, HG_VW)


def _axial_rope_tables(L):
    rows = L // GRID_W
    row = jnp.repeat(jnp.arange(rows), GRID_W).astype(jnp.float32)
    col = jnp.tile(jnp.arange(GRID_W), rows).astype(jnp.float32)
    axis_dim = ATT_DH // 2
    freqs = ROPE_THETA ** (-jnp.arange(0, axis_dim, 2, dtype=jnp.float32) / axis_dim)
    ang = jnp.concatenate([row[:, None] * freqs, col[:, None] * freqs], axis=-1)
    return jnp.cos(ang), jnp.sin(ang)


def _apply_rope(x, cos, sin):
    xf = x.astype(jnp.float32)
    x1, x2 = xf[..., 0::2], xf[..., 1::2]
    c, s = cos[None, :, None, :], sin[None, :, None, :]
    out = jnp.stack([x1 * c - x2 * s, x1 * s + x2 * c], axis=-1).reshape(x.shape)
    return out.astype(x.dtype)


def _block_attention(q, k, v):
    B, L, _, dh = q.shape
    nq = L // Q_BLOCK
    qb = q.reshape(B, nq, Q_BLOCK, ATT_KV_HEADS, ATT_GROUP, dh).transpose(1, 0, 3, 4, 2, 5)
    kt = k.transpose(0, 2, 1, 3)
    vt = v.transpose(0, 2, 1, 3)
    scale = dh ** -0.5

    def one_block(qblk):
        s = jnp.einsum('bhgqd,bhkd->bhgqk', qblk, kt).astype(jnp.float32) * scale
        p = jax.nn.softmax(s, axis=-1)
        return jnp.einsum('bhgqk,bhkd->bhgqd', p.astype(vt.dtype), vt)

    o = lax.map(one_block, qb)
    return o.transpose(1, 0, 4, 2, 3, 5).reshape(B, L, ATT_QW)


def _attention_group(u_q, u_k, u_v, q_norm_w, k_norm_w, out_norm_w):
    B, L, _ = u_q.shape
    q = _rmsnorm(u_q.reshape(B, L, ATT_HEADS, ATT_DH), q_norm_w)
    k = _rmsnorm(u_k.reshape(B, L, ATT_KV_HEADS, ATT_DH), k_norm_w)
    v = u_v.reshape(B, L, ATT_KV_HEADS, ATT_DH)
    cos, sin = _axial_rope_tables(L)
    q, k = _apply_rope(q, cos, sin), _apply_rope(k, cos, sin)
    o = _block_attention(q, k, v)
    return _rmsnorm(o, out_norm_w)


def setup_inputs(seed: int = 0) -> dict:
    key = jax.random.key(seed)
    ks = jax.random.split(key, 16)
    f32 = jnp.float32
    gain = lambda k, shape: 1.0 + 0.02 * jax.random.normal(k, shape, f32)
    return {
        "x": jax.random.normal(ks[0], (BATCH, SEQ, D_MODEL), f32),
        "norm1_w": gain(ks[1], (DEPTH, D_MODEL)),
        "w_in": jax.random.normal(ks[2], (DEPTH, D_MODEL, D_IN), f32) * D_MODEL ** -0.5,
        "lb_logits": 0.5 * jax.random.normal(ks[3], (2, DEPTH + 1, HG_KW), f32),
        "hg_norm_w": gain(ks[4], (DEPTH, HG_DV)),
        "q_norm_w": gain(ks[5], (DEPTH, ATT_DH)),
        "k_norm_w": gain(ks[6], (DEPTH, ATT_DH)),
        "att_norm_w": gain(ks[7], (DEPTH, ATT_QW)),
        "w_out": jax.random.normal(ks[8], (DEPTH, D_MIX, D_MODEL), f32) * D_MIX ** -0.5,
        "norm2_w": gain(ks[9], (DEPTH, D_MODEL)),
        "w_gate_up": jax.random.normal(ks[10], (DEPTH, D_MODEL, 2 * D_FF), f32) * D_MODEL ** -0.5,
        "w_down": jax.random.normal(ks[11], (DEPTH, D_FF, D_MODEL), f32) * D_FF ** -0.5,
        "final_norm_w": gain(ks[12], (D_MODEL,)),
    }


def reference(x, norm1_w, w_in, lb_logits, hg_norm_w, q_norm_w, k_norm_w, att_norm_w,
              w_out, norm2_w, w_gate_up, w_down, final_norm_w):
    lb_all = jnp.cumsum(jax.nn.softmax(lb_logits.astype(jnp.float32), axis=1), axis=1)
    splits = np.cumsum([HG_KW, HG_KW, HG_KW, HG_VW, HG_VW, ATT_QW, ATT_KVW]).tolist()
    for l in range(DEPTH):
        h = _rmsnorm(x, norm1_w[l])
        u = jnp.einsum('bld,de->ble', h, w_in[l])
        u_q, u_ff, u_fb, u_i, u_g, a_q, a_k, a_v = jnp.split(u, splits, axis=-1)
        o_hg = _hgrn2_group(u_q, u_ff, u_fb, u_i, u_g, lb_all[0, l], lb_all[1, l], hg_norm_w[l])
        o_att = _attention_group(a_q, a_k, a_v, q_norm_w[l], k_norm_w[l], att_norm_w[l])
        mix = jnp.concatenate([o_hg, o_att], axis=-1)
        x = x + jnp.einsum('ble,ed->bld', mix, w_out[l])
        h2 = _rmsnorm(x, norm2_w[l])
        gate, up = jnp.split(jnp.einsum('bld,df->blf', h2, w_gate_up[l]), 2, axis=-1)
        x = x + jnp.einsum('blf,fd->bld', jax.nn.silu(gate) * up, w_down[l])
    return _rmsnorm(x, final_norm_w)
```

```cpp
#include <hip/hip_runtime.h>
#include <hip/hip_cooperative_groups.h>
#include <cstdio>
#include <cstdint>
namespace cg = cooperative_groups;

#ifndef MK_N_LAUNCHES
#define MK_N_LAUNCHES 1
#endif

#define LAS __attribute__((address_space(3)))
typedef unsigned short bf16_t;
typedef short bf16x8 __attribute__((ext_vector_type(8)));
typedef short bf16x4 __attribute__((ext_vector_type(4)));
typedef float f32x2 __attribute__((ext_vector_type(2)));
typedef float f32x4 __attribute__((ext_vector_type(4)));
typedef float f32x16 __attribute__((ext_vector_type(16)));
typedef unsigned u32x2 __attribute__((ext_vector_type(2)));
typedef unsigned u32x4 __attribute__((ext_vector_type(4)));

constexpr int BATCH = 2, SEQ = 8192, M = BATCH * SEQ, D = 1024, DIN = 3328, DFF = 2816;
constexpr float EPS = 1e-6f;
constexpr float C2 = 0.125f * 1.4426950408889634f;
constexpr int NPH = 8;
constexpr int NTHREADS = 512, NWAVES = 8;
constexpr int LDS_BYTES = 147456;

constexpr size_t MiB = 1u << 20;
constexpr size_t WS_CTL = 0, CTL_ZERO_BYTES = 1 * MiB;
constexpr size_t CTL_SSATT = 64 * 1024, CTL_SS2 = 128 * 1024, CTL_SS3 = 192 * 1024, CTL_LB = 256 * 1024;
constexpr size_t WS_WIN = 1 * MiB, WS_WOUT = 8 * MiB, WS_WGU = 10 * MiB, WS_WDN = 21 * MiB;
constexpr size_t WS_XN = 27 * MiB;
constexpr size_t WS_QH = 59 * MiB;
constexpr size_t WS_IV = 75 * MiB;
constexpr size_t WS_GH = 91 * MiB;
constexpr size_t WS_ZF = 107 * MiB;
constexpr size_t WS_AQKV = 171 * MiB;
constexpr size_t WS_MIX = 171 * MiB;
constexpr size_t WS_QA = 219 * MiB;
constexpr size_t WS_KA = 235 * MiB;
constexpr size_t WS_VA = 239 * MiB;
constexpr size_t WS_VT = 243 * MiB;
constexpr size_t WS_XB = 59 * MiB;
constexpr size_t WS_H = 91 * MiB;
constexpr size_t WS_END = 256 * MiB;
static_assert(WS_WDN + (size_t)D * DFF * 2 <= WS_XN && WS_H + (size_t)M * DFF * 2 <= WS_QA && WS_VT + (size_t)4 * 64 * SEQ * 2 <= WS_END, "ws map");

struct Params {
    const float* x; const float* norm1_w; const float* w_in; const float* lb_logits; const float* hg_norm_w; const float* q_norm_w; const float* k_norm_w;
    const float* att_norm_w; const float* w_out; const float* norm2_w; const float* w_gate_up; const float* w_down; const float* final_norm_w;
    float* out; unsigned char* ws; int ph_lo, ph_hi;
};

__device__ __forceinline__ unsigned f2bf(float f) { unsigned u = __builtin_bit_cast(unsigned, f); return (u + 0x7fffu + ((u >> 16) & 1u)) >> 16; }
__device__ __forceinline__ unsigned pk2(float lo, float hi) { return f2bf(lo) | (f2bf(hi) << 16); }
__device__ __forceinline__ float bf2f(bf16_t b) { return __builtin_bit_cast(float, (unsigned)b << 16); }
__device__ __forceinline__ float silu_f(float v) { return v * __builtin_amdgcn_rcpf(1.f + __builtin_amdgcn_exp2f(-1.4426950408889634f * v)); }
__device__ __forceinline__ float sigmoid_f(float v) { return __builtin_amdgcn_rcpf(1.f + __builtin_amdgcn_exp2f(-1.4426950408889634f * v)); }
__device__ __forceinline__ int crow(int r, int hi) { return (r & 3) + 8 * (r >> 2) + 4 * hi; }
__device__ __forceinline__ float wave_sum(float v) {
#pragma unroll
    for (int o = 1; o < 64; o <<= 1) v += __shfl_xor(v, o);
    return v;
}

__device__ __forceinline__ void transpose_item(const float* W, int N, bf16_t* WT, int Kd, int k_src0, int k_dst0, int n_src0, int n_dst0, const float* sc, LAS float* scr, int lane) {
#pragma unroll 8
    for (int i = 0; i < 32; ++i) { const int kk = 2 * i + (lane >> 5); float v = W[(size_t)(k_src0 + kk) * N + n_src0 + (lane & 31)]; if (sc) v *= sc[k_src0 + kk]; scr[kk * 33 + (lane & 31)] = v; }
    asm volatile("s_waitcnt lgkmcnt(0)" ::: "memory");
    const int c = lane & 7;
#pragma unroll
    for (int j = 0; j < 4; ++j) { const int n = (lane >> 3) + 8 * j; const LAS float* s = scr + (8 * c) * 33 + n;
        u32x4 o; o.x = pk2(s[0 * 33], s[1 * 33]); o.y = pk2(s[2 * 33], s[3 * 33]); o.z = pk2(s[4 * 33], s[5 * 33]); o.w = pk2(s[6 * 33], s[7 * 33]);
        *(u32x4*)(WT + (size_t)(n_dst0 + n) * Kd + k_dst0 + 8 * c) = o; }
    asm volatile("s_waitcnt lgkmcnt(0)" ::: "memory");
}

__device__ __forceinline__ void p0_prologue(const Params& p, LAS unsigned char* lds, int bid, int nb) {
    const int tid = threadIdx.x, lane = tid & 63, wave = tid >> 6;
    LAS float* scr = (LAS float*)(lds + wave * 16384);
    const int gw = bid * NWAVES + wave, NGW = nb * NWAVES;
    bf16_t* Win_t = (bf16_t*)(p.ws + WS_WIN); bf16_t* Wout_t = (bf16_t*)(p.ws + WS_WOUT); bf16_t* Wgu_t = (bf16_t*)(p.ws + WS_WGU); bf16_t* Wdn_t = (bf16_t*)(p.ws + WS_WDN);
    constexpr int I_IN = (D / 64) * (DIN / 32), I_OUT = (D / 64) * (D / 32), I_GU = (D / 64) * (2 * DFF / 32), I_DN = (DFF / 64) * (D / 32);
    constexpr int NITEMS = I_IN + I_OUT + I_GU + I_DN;
    for (int it = gw; it < NITEMS; it += NGW) {
        int r = it;
        if (r < I_IN) { const int nblk = DIN / 32, kb = r / nblk, nbk = r % nblk; transpose_item(p.w_in, DIN, Win_t, D, 64 * kb, 64 * kb, 32 * nbk, 32 * nbk, nullptr, scr, lane); continue; } r -= I_IN;
        if (r < I_OUT) { const int nblk = D / 32, kb = r / nblk, nbk = r % nblk; const int ks = 64 * kb;
            transpose_item(p.w_out, D, Wout_t, D, ks, (ks + 512) & 1023, 32 * nbk, 32 * nbk, ks >= 512 ? p.att_norm_w - 512 : nullptr, scr, lane); continue; } r -= I_OUT;
        if (r < I_GU) { const int nblk = 2 * DFF / 32, kb = r / nblk, nbk = r % nblk; const int nd = 32 * nbk, pn = nd >> 8, nn = nd & 255;
            const int ns = nn < 128 ? 128 * pn + nn : DFF + 128 * pn + nn - 128;
            transpose_item(p.w_gate_up, 2 * DFF, Wgu_t, D, 64 * kb, 64 * kb, ns, nd, p.norm2_w, scr, lane); continue; } r -= I_GU;
        { const int nblk = D / 32, kb = r / nblk, nbk = r % nblk; transpose_item(p.w_down, D, Wdn_t, DFF, 64 * kb, 64 * kb, 32 * nbk, 32 * nbk, nullptr, scr, lane); }
    }
    bf16_t* XN = (bf16_t*)(p.ws + WS_XN);
    for (int m = gw; m < M; m += NGW) {
        const f32x4* xr = (const f32x4*)(p.x + (size_t)m * D) + lane; const f32x4* wr = (const f32x4*)p.norm1_w + lane;
        f32x4 v[4]; float s = 0.f;
#pragma unroll
        for (int j = 0; j < 4; ++j) { v[j] = xr[64 * j]; s += (v[j].x * v[j].x + v[j].y * v[j].y) + (v[j].z * v[j].z + v[j].w * v[j].w); }
        const float rstd = 1.f / sqrtf(wave_sum(s) * (1.f / D) + EPS);
        unsigned long long* o8 = (unsigned long long*)(XN + (size_t)m * D) + lane;
#pragma unroll
        for (int j = 0; j < 4; ++j) { const f32x4 w = wr[64 * j]; o8[64 * j] = (unsigned long long)pk2(v[j].x * rstd * w.x, v[j].y * rstd * w.y) | ((unsigned long long)pk2(v[j].z * rstd * w.z, v[j].w * rstd * w.w) << 32); }
    }
    if (bid == 0) { float* LB = (float*)(p.ws + WS_CTL + CTL_LB);
        for (int j = tid; j < 1024; j += NTHREADS) { const int d = j >> 9, jj = j & 511; const float a0 = p.lb_logits[d * 1024 + jj], a1 = p.lb_logits[d * 1024 + 512 + jj]; LB[j] = 1.f / (1.f + expf(a1 - a0)); } }
}

struct EpiIn {
    static constexpr bool PAIR = false, MID = false;
    bf16_t* QH; float* ZF; bf16_t* IV; bf16_t* GH; float* AQKV; const float* LB;
    __device__ __forceinline__ void elem(int row, int col, float v) const {
        if (col < 512) QH[(size_t)row * 512 + col] = (bf16_t)f2bf(silu_f(v));
        else if (col < 1536) { const int c = col - 512; const float lb = LB[c]; ZF[(size_t)row * 1024 + c] = lb + (1.f - lb) * sigmoid_f(v); }
        else if (col < 2048) IV[(size_t)row * 512 + col - 1536] = (bf16_t)f2bf(v);
        else if (col < 2560) GH[(size_t)row * 512 + col - 2048] = (bf16_t)f2bf(silu_f(v));
        else AQKV[(size_t)row * 768 + col - 2560] = v;
    }
    __device__ __forceinline__ void naive(f32x16 (&acc)[2][2], int row0, int col0, int cs, int r32, int hi) const {
#pragma unroll
        for (int i = 0; i < 2; ++i)
#pragma unroll
            for (int j = 0; j < 2; ++j)
#pragma unroll
                for (int r = 0; r < 16; ++r) elem(row0 + 32 * i + crow(r, hi), col0 + j * cs + r32, acc[i][j][r]);
    }
    __device__ __forceinline__ void mid(f32x16 (&)[2][2], int, int, int) const {}
};
struct EpiOut {
    static constexpr bool PAIR = false, MID = true; static constexpr int MIDK = 512;
    const float* x; float* out; bf16_t* XB; float* ss2; const float* ssatt;
    __device__ __forceinline__ void mid(f32x16 (&acc)[2][2], int row0, int r32, int hi) const {
#pragma unroll
        for (int i = 0; i < 2; ++i)
#pragma unroll
            for (int r = 0; r < 16; ++r) { const float s = 1.f / sqrtf(ssatt[row0 + 32 * i + crow(r, hi)] * (1.f / 512.f) + EPS); acc[i][0][r] *= s; acc[i][1][r] *= s; }
    }
    __device__ __forceinline__ void naive(f32x16 (&acc)[2][2], int row0, int col0, int cs, int r32, int hi) const {
#pragma unroll
        for (int i = 0; i < 2; ++i)
#pragma unroll
            for (int r = 0; r < 16; ++r) { const int row = row0 + 32 * i + crow(r, hi); float q = 0.f;
#pragma unroll
                for (int j = 0; j < 2; ++j) { const size_t idx = (size_t)row * D + col0 + j * cs + r32; const float v = x[idx] + acc[i][j][r]; out[idx] = v; XB[idx] = (bf16_t)f2bf(v); q += v * v; }
#pragma unroll
                for (int o = 1; o < 32; o <<= 1) q += __shfl_xor(q, o);
                if (r32 == 0) atomicAdd(ss2 + row, q); }
    }
};
struct EpiGU {
    static constexpr bool PAIR = true, MID = false;
    bf16_t* H; const float* ss2;
    __device__ __forceinline__ void naive(f32x16 (&acc)[2][2], int row0, int col0, int cs, int r32, int hi) const {
        const int pn = col0 >> 8, cc = (col0 & 255) + r32;
#pragma unroll
        for (int i = 0; i < 2; ++i)
#pragma unroll
            for (int r = 0; r < 16; ++r) { const int row = row0 + 32 * i + crow(r, hi); const float s = 1.f / sqrtf(ss2[row] * (1.f / D) + EPS);
                H[(size_t)row * DFF + 128 * pn + cc] = (bf16_t)f2bf(silu_f(acc[i][0][r] * s) * (acc[i][1][r] * s)); }
    }
    __device__ __forceinline__ void mid(f32x16 (&)[2][2], int, int, int) const {}
};
struct EpiDown {
    static constexpr bool PAIR = false, MID = false;
    float* out; float* ss3;
    __device__ __forceinline__ void naive(f32x16 (&acc)[2][2], int row0, int col0, int cs, int r32, int hi) const {
#pragma unroll
        for (int i = 0; i < 2; ++i)
#pragma unroll
            for (int r = 0; r < 16; ++r) { const int row = row0 + 32 * i + crow(r, hi); float q = 0.f;
#pragma unroll
                for (int j = 0; j < 2; ++j) { const size_t idx = (size_t)row * D + col0 + j * cs + r32; const float v = out[idx] + acc[i][j][r]; out[idx] = v; q += v * v; }
#pragma unroll
                for (int o = 1; o < 32; o <<= 1) q += __shfl_xor(q, o);
                if (r32 == 0) atomicAdd(ss3 + row, q); }
    }
    __device__ __forceinline__ void mid(f32x16 (&)[2][2], int, int, int) const {}
};

template <class Epi>
__device__ __forceinline__ void ngemm_phase(const bf16_t* A, const bf16_t* Bt, int M_, int N_, int K_, const Epi& E, int bid, int nb) {
    const int tid = threadIdx.x, lane = tid & 63, wid = tid >> 6, r32 = lane & 31, hi = lane >> 5, wr = wid >> 2, wc = wid & 3;
    const int nM = M_ / 128, nN = N_ / 256; constexpr int CS = Epi::PAIR ? 128 : 32;
    for (int u = bid; u < nM * nN; u += nb) {
        const int pm = u / nN, pn = u % nN;
        const int row0 = pm * 128 + wr * 64, col0 = pn * 256 + (Epi::PAIR ? wc * 32 : wc * 64);
        f32x16 acc[2][2];
#pragma unroll
        for (int i = 0; i < 2; ++i)
#pragma unroll
            for (int j = 0; j < 2; ++j)
#pragma unroll
                for (int r = 0; r < 16; ++r) acc[i][j][r] = 0.f;
        const bf16_t* a0 = A + (size_t)(row0 + r32) * K_ + hi * 8; const bf16_t* a1 = a0 + (size_t)32 * K_;
        const bf16_t* b0 = Bt + (size_t)(col0 + r32) * K_ + hi * 8; const bf16_t* b1 = b0 + (size_t)CS * K_;
        for (int k = 0; k < K_; k += 16) {
            if constexpr (Epi::MID) { if (k == Epi::MIDK) E.mid(acc, row0, r32, hi); }
            const bf16x8 fa0 = *(const bf16x8*)(a0 + k), fa1 = *(const bf16x8*)(a1 + k), fb0 = *(const bf16x8*)(b0 + k), fb1 = *(const bf16x8*)(b1 + k);
            acc[0][0] = __builtin_amdgcn_mfma_f32_32x32x16_bf16(fa0, fb0, acc[0][0], 0, 0, 0);
            acc[0][1] = __builtin_amdgcn_mfma_f32_32x32x16_bf16(fa0, fb1, acc[0][1], 0, 0, 0);
            acc[1][0] = __builtin_amdgcn_mfma_f32_32x32x16_bf16(fa1, fb0, acc[1][0], 0, 0, 0);
            acc[1][1] = __builtin_amdgcn_mfma_f32_32x32x16_bf16(fa1, fb1, acc[1][1], 0, 0, 0);
        }
        E.naive(acc, row0, col0, CS, r32, hi);
    }
}

__device__ __forceinline__ void rope_pair(float x1, float x2, int pi  , int t, float& o1, float& o2) {
    const int pos = pi < 16 ? (t >> 6) : (t & 63); const int fi = pi & 15;
    const float freq = exp2f(-(float)fi * (13.287712379549449f / 16.f));
    const float ang = (float)pos * freq; float rev = ang * 0.15915494309189535f; rev -= rintf(rev);
    const float s = __builtin_amdgcn_sinf(rev), c = __builtin_amdgcn_cosf(rev);
    o1 = x1 * c - x2 * s; o2 = x1 * s + x2 * c;
}
__device__ __forceinline__ void p2_qkconvert(const Params& p, int bid, int nb) {
    const int tid = threadIdx.x, lane = tid & 63, wave = tid >> 6; const int gw = bid * NWAVES + wave, NGW = nb * NWAVES;
    const float* AQKV = (const float*)(p.ws + WS_AQKV); bf16_t* QA = (bf16_t*)(p.ws + WS_QA); bf16_t* KA = (bf16_t*)(p.ws + WS_KA); bf16_t* VA = (bf16_t*)(p.ws + WS_VA); bf16_t* VT = (bf16_t*)(p.ws + WS_VT);
    const int pi = lane & 31;
    const f32x2 qw = *((const f32x2*)p.q_norm_w + pi), kw = *((const f32x2*)p.k_norm_w + pi);
    for (int m = gw; m < M; m += NGW) {
        const int t = m & (SEQ - 1), b = m >> 13; const float* row = AQKV + (size_t)m * 768;
#pragma unroll
        for (int j = 0; j < 4; ++j) {
            const f32x2 v = *((const f32x2*)row + 64 * j + lane); float ss = v.x * v.x + v.y * v.y;
#pragma unroll
            for (int o = 1; o < 32; o <<= 1) ss += __shfl_xor(ss, o);
            const float rstd = 1.f / sqrtf(ss * (1.f / 64.f) + EPS); float o1, o2; rope_pair(v.x * rstd * qw.x, v.y * rstd * qw.y, pi, t, o1, o2);
            *((unsigned*)(QA + (size_t)m * 512) + 64 * j + lane) = pk2(o1 * C2, o2 * C2);
        }
        {
            const f32x2 v = *((const f32x2*)(row + 512) + lane); float ss = v.x * v.x + v.y * v.y;
#pragma unroll
            for (int o = 1; o < 32; o <<= 1) ss += __shfl_xor(ss, o);
            const float rstd = 1.f / sqrtf(ss * (1.f / 64.f) + EPS); float o1, o2; rope_pair(v.x * rstd * kw.x, v.y * rstd * kw.y, pi, t, o1, o2);
            *((unsigned*)(KA + (size_t)m * 128) + lane) = pk2(o1, o2);
        }
        {
            const f32x2 v = *((const f32x2*)(row + 640) + lane); const unsigned w = pk2(v.x, v.y);
            *((unsigned*)(VA + (size_t)m * 128) + lane) = w;
            const int kvh = lane >> 5, d = 2 * (lane & 31);
            bf16_t* vt = VT + ((size_t)(b * 2 + kvh) * 64 + d) * SEQ + t; vt[0] = (bf16_t)(w & 0xffffu); vt[SEQ] = (bf16_t)(w >> 16);
        }
    }
}

__device__ __forceinline__ void nattn_unit(const bf16_t* QA, const bf16_t* KA, const bf16_t* VT, bf16_t* MIX, float* ssatt, int wu, int lane) {
    const int r32 = lane & 31, hi = lane >> 5; const int b = wu >> 11, hq = (wu >> 8) & 7, qb = wu & 255, kvh = hq >> 2;
    const size_t rowbase = (size_t)b * SEQ;
    const bf16_t* Qp = QA + (rowbase + qb * 32 + r32) * 512 + hq * 64 + hi * 8;
    bf16x8 qf[4];
#pragma unroll
    for (int d0 = 0; d0 < 4; ++d0) qf[d0] = *(const bf16x8*)(Qp + d0 * 16);
    const bf16_t* Kp = KA + (rowbase + r32) * 128 + kvh * 64 + hi * 8;
    const bf16_t* Vp = VT + ((size_t)(b * 2 + kvh) * 64 + r32) * SEQ + 4 * hi;
    f32x16 o0, o1;
#pragma unroll
    for (int r = 0; r < 16; ++r) { o0[r] = 0.f; o1[r] = 0.f; }
    float mrun = -1e30f, l = 0.f;
    for (int kv0 = 0; kv0 < SEQ; kv0 += 32) {
        f32x16 s;
#pragma unroll
        for (int r = 0; r < 16; ++r) s[r] = 0.f;
#pragma unroll
        for (int d0 = 0; d0 < 4; ++d0) { const bf16x8 kf = *(const bf16x8*)(Kp + (size_t)kv0 * 128 + d0 * 16); s = __builtin_amdgcn_mfma_f32_32x32x16_bf16(kf, qf[d0], s, 0, 0, 0); }
        float mx = s[0];
#pragma unroll
        for (int r = 1; r < 16; ++r) mx = fmaxf(mx, s[r]);
        mx = fmaxf(mx, __shfl_xor(mx, 32));
        const float mn = fmaxf(mrun, mx), alpha = __builtin_amdgcn_exp2f(mrun - mn); mrun = mn;
        float ps = 0.f;
#pragma unroll
        for (int r = 0; r < 16; ++r) { s[r] = __builtin_amdgcn_exp2f(s[r] - mn); ps += s[r]; }
        l = l * alpha + ps;
#pragma unroll
        for (int r = 0; r < 16; ++r) { o0[r] *= alpha; o1[r] *= alpha; }
#pragma unroll
        for (int si = 0; si < 2; ++si) {
            u32x4 pw; pw.x = pk2(s[8 * si + 0], s[8 * si + 1]); pw.y = pk2(s[8 * si + 2], s[8 * si + 3]); pw.z = pk2(s[8 * si + 4], s[8 * si + 5]); pw.w = pk2(s[8 * si + 6], s[8 * si + 7]);
            const bf16x8 pb = __builtin_bit_cast(bf16x8, pw);
            const bf16_t* vp = Vp + kv0 + 16 * si;
            { const bf16x4 lo = *(const bf16x4*)vp, h4 = *(const bf16x4*)(vp + 8); const bf16x8 vf = {lo[0], lo[1], lo[2], lo[3], h4[0], h4[1], h4[2], h4[3]}; o0 = __builtin_amdgcn_mfma_f32_32x32x16_bf16(vf, pb, o0, 0, 0, 0); }
            { const bf16_t* vq = vp + (size_t)32 * SEQ; const bf16x4 lo = *(const bf16x4*)vq, h4 = *(const bf16x4*)(vq + 8); const bf16x8 vf = {lo[0], lo[1], lo[2], lo[3], h4[0], h4[1], h4[2], h4[3]}; o1 = __builtin_amdgcn_mfma_f32_32x32x16_bf16(vf, pb, o1, 0, 0, 0); }
        }
    }
    l += __shfl_xor(l, 32); const float rl = 1.f / l; const size_t row = rowbase + qb * 32 + r32; float q = 0.f;
#pragma unroll
    for (int r = 0; r < 16; ++r) { const float a = o0[r] * rl, c = o1[r] * rl; q += a * a + c * c;
        MIX[row * 1024 + hq * 64 + crow(r, hi)] = (bf16_t)f2bf(a); MIX[row * 1024 + hq * 64 + 32 + crow(r, hi)] = (bf16_t)f2bf(c); }
    q += __shfl_xor(q, 32);
    if (hi == 0) atomicAdd(ssatt + row, q);
}

__device__ __forceinline__ void nhgrn_unit(const Params& p, LAS unsigned char* lds, int bh) {
    const int b = bh >> 2, h = bh & 3, tid = threadIdx.x, v = tid >> 2, kq = tid & 3;
    LAS float* Fs = (LAS float*)lds; LAS float* Qs = Fs + 8192; LAS float* Vs = Qs + 8192; LAS float* OL = Vs + 8192;
    const float* ZF = (const float*)(p.ws + WS_ZF); const bf16_t* QH = (const bf16_t*)(p.ws + WS_QH); const bf16_t* IV = (const bf16_t*)(p.ws + WS_IV); const bf16_t* GH = (const bf16_t*)(p.ws + WS_GH);
    float* OF = (float*)(p.ws + WS_XN); bf16_t* MIX = (bf16_t*)(p.ws + WS_MIX);
    for (int dir = 0; dir < 2; ++dir) {
        float S[32];
#pragma unroll
        for (int i = 0; i < 32; ++i) S[i] = 0.f;
        for (int cc = 0; cc < SEQ / 64; ++cc) {
            const int c = dir ? SEQ / 64 - 1 - cc : cc; const size_t r0 = (size_t)b * SEQ + c * 64;
#pragma unroll 4
            for (int i = 0; i < 16; ++i) { const int e = tid + 512 * i, tt = e >> 7, k = e & 127; const size_t row = r0 + tt;
                Fs[e] = ZF[row * 1024 + dir * 512 + h * 128 + k]; Qs[e] = bf2f(QH[row * 512 + h * 128 + k]); Vs[e] = bf2f(IV[row * 512 + h * 128 + k]); }
            __syncthreads();
            for (int s = 0; s < 64; ++s) { const int tt = dir ? 63 - s : s; const float vt = Vs[tt * 128 + v]; float o = 0.f;
#pragma unroll
                for (int kk = 0; kk < 32; kk += 4) { const f32x4 f = *(const LAS f32x4*)&Fs[tt * 128 + kq * 32 + kk], q = *(const LAS f32x4*)&Qs[tt * 128 + kq * 32 + kk];
                    S[kk + 0] = f.x * S[kk + 0] + (1.f - f.x) * vt; o += S[kk + 0] * q.x; S[kk + 1] = f.y * S[kk + 1] + (1.f - f.y) * vt; o += S[kk + 1] * q.y;
                    S[kk + 2] = f.z * S[kk + 2] + (1.f - f.z) * vt; o += S[kk + 2] * q.z; S[kk + 3] = f.w * S[kk + 3] + (1.f - f.w) * vt; o += S[kk + 3] * q.w; }
                o += __shfl_xor(o, 1); o += __shfl_xor(o, 2);
                if (kq == 0) OL[tt * 128 + v] = o; }
            __syncthreads();
            if (dir == 0) {
#pragma unroll 4
                for (int i = 0; i < 16; ++i) { const int e = tid + 512 * i, tt = e >> 7, k = e & 127; OF[(r0 + tt) * 512 + h * 128 + k] = OL[e]; }
            } else { const int tt = tid >> 3, sg = tid & 7; const size_t row = r0 + tt; float tot[16]; float ss = 0.f;
#pragma unroll
                for (int j = 0; j < 16; ++j) { const int vv = sg * 16 + j; tot[j] = OL[tt * 128 + vv] + OF[row * 512 + h * 128 + vv]; ss += tot[j] * tot[j]; }
                ss += __shfl_xor(ss, 1); ss += __shfl_xor(ss, 2); ss += __shfl_xor(ss, 4);
                const float rstd = 1.f / sqrtf(ss * (1.f / 128.f) + EPS);
#pragma unroll
                for (int j = 0; j < 16; ++j) { const int vv = sg * 16 + j; MIX[row * 1024 + 512 + h * 128 + vv] = (bf16_t)f2bf(tot[j] * rstd * p.hg_norm_w[vv] * bf2f(GH[row * 512 + h * 128 + vv])); }
            }
            __syncthreads();
        }
    }
}

__global__ void __launch_bounds__(NTHREADS, 2) fwd_kernel(Params p) {
    extern __shared__ __attribute__((aligned(16))) unsigned char lds_raw[];
    LAS unsigned char* lds = (LAS unsigned char*)lds_raw;
    cg::grid_group grid = cg::this_grid();
    const int bid = blockIdx.x, nb = gridDim.x, tid = threadIdx.x, lane = tid & 63, wave = tid >> 6;
    const int lo = p.ph_lo, hi = p.ph_hi;
#define IN(k) (lo <= (k) && (k) < hi)
#define SEAM(k) do { if (IN(k) && IN((k) + 1)) grid.sync(); } while (0)
    unsigned char* ws = p.ws;
    float* ssatt = (float*)(ws + WS_CTL + CTL_SSATT); float* ss2 = (float*)(ws + WS_CTL + CTL_SS2); float* ss3 = (float*)(ws + WS_CTL + CTL_SS3); const float* LB = (const float*)(ws + WS_CTL + CTL_LB);

    if (IN(0)) { p0_prologue(p, lds, bid, nb); } SEAM(0);
    if (IN(1)) { EpiIn E{(bf16_t*)(ws + WS_QH), (float*)(ws + WS_ZF), (bf16_t*)(ws + WS_IV), (bf16_t*)(ws + WS_GH), (float*)(ws + WS_AQKV), LB};
        ngemm_phase(( const bf16_t*)(ws + WS_XN), (const bf16_t*)(ws + WS_WIN), M, DIN, D, E, bid, nb); } SEAM(1);
    if (IN(2)) { p2_qkconvert(p, bid, nb); } SEAM(2);
    if (IN(3)) {
        if (bid < 8 && nb > 8) nhgrn_unit(p, lds, bid);
        else { const int ab = nb > 8 ? bid - 8 : bid, anb = nb > 8 ? nb - 8 : nb;
            if (nb <= 8) { for (int u = bid; u < 8; u += nb) nhgrn_unit(p, lds, u); }
            for (int wu = ab * NWAVES + wave; wu < 4096; wu += anb * NWAVES)
                nattn_unit((const bf16_t*)(ws + WS_QA), (const bf16_t*)(ws + WS_KA), (const bf16_t*)(ws + WS_VT), (bf16_t*)(ws + WS_MIX), ssatt, wu, lane); }
    } SEAM(3);
    if (IN(4)) { EpiOut E{p.x, p.out, (bf16_t*)(ws + WS_XB), ss2, ssatt};
        ngemm_phase((const bf16_t*)(ws + WS_MIX), (const bf16_t*)(ws + WS_WOUT), M, D, D, E, bid, nb); } SEAM(4);
    if (IN(5)) { EpiGU E{(bf16_t*)(ws + WS_H), ss2};
        ngemm_phase((const bf16_t*)(ws + WS_XB), (const bf16_t*)(ws + WS_WGU), M, 2 * DFF, D, E, bid, nb); } SEAM(5);
    if (IN(6)) { EpiDown E{p.out, ss3};
        ngemm_phase((const bf16_t*)(ws + WS_H), (const bf16_t*)(ws + WS_WDN), M, D, DFF, E, bid, nb); } SEAM(6);
    if (IN(7)) {
        const int gw = bid * NWAVES + wave, NGW = nb * NWAVES;
        for (int m = gw; m < M; m += NGW) { f32x4* xr = (f32x4*)(p.out + (size_t)m * D) + lane; const f32x4* wr = (const f32x4*)p.final_norm_w + lane;
            const float rstd = 1.f / sqrtf(ss3[m] * (1.f / D) + EPS);
#pragma unroll
            for (int j = 0; j < 4; ++j) { f32x4 v = xr[64 * j]; const f32x4 w = wr[64 * j]; v.x *= rstd * w.x; v.y *= rstd * w.y; v.z *= rstd * w.z; v.w *= rstd * w.w; xr[64 * j] = v; } }
    }
#undef IN
#undef SEAM
}

extern "C" void kernel_launch(void* const* d_in, const int* in_sizes, int n_in, void* d_out, int out_size, void* d_ws, size_t ws_size, hipStream_t stream) {
    static int grid = 0;
    if (grid == 0) {
        if (n_in != 13 || in_sizes[0] != M * D || out_size != M * D || ws_size < WS_END) { fprintf(stderr, "kernel_launch: unexpected shapes (n_in %d, in0 %d, out %d, ws %zu)\n", n_in, n_in > 0 ? in_sizes[0] : -1, out_size, ws_size); grid = -1; return; }
        int dev = 0, cus = 0, per_cu = 0;
        hipGetDevice(&dev); hipDeviceGetAttribute(&cus, hipDeviceAttributeMultiprocessorCount, dev);
        if (hipFuncSetAttribute((const void*)fwd_kernel, hipFuncAttributeMaxDynamicSharedMemorySize, LDS_BYTES) != hipSuccess) { fprintf(stderr, "kernel_launch: hipFuncSetAttribute failed\n"); grid = -1; return; }
        if (hipOccupancyMaxActiveBlocksPerMultiprocessor(&per_cu, (const void*)fwd_kernel, NTHREADS, LDS_BYTES) != hipSuccess || per_cu < 1) { fprintf(stderr, "kernel_launch: occupancy query says %d\n", per_cu); per_cu = 1; }
        (void)hipGetLastError();
        grid = cus;
    }
    if (grid < 0) return;
    hipMemsetAsync((char*)d_ws + WS_CTL, 0, CTL_ZERO_BYTES, stream);
    Params p{};
    p.x = (const float*)d_in[0]; p.norm1_w = (const float*)d_in[1]; p.w_in = (const float*)d_in[2]; p.lb_logits = (const float*)d_in[3]; p.hg_norm_w = (const float*)d_in[4];
    p.q_norm_w = (const float*)d_in[5]; p.k_norm_w = (const float*)d_in[6]; p.att_norm_w = (const float*)d_in[7]; p.w_out = (const float*)d_in[8]; p.norm2_w = (const float*)d_in[9];
    p.w_gate_up = (const float*)d_in[10]; p.w_down = (const float*)d_in[11]; p.final_norm_w = (const float*)d_in[12];
    p.out = (float*)d_out; p.ws = (unsigned char*)d_ws;
#if MK_N_LAUNCHES == 1
    p.ph_lo = 0; p.ph_hi = NPH;
    void* args[] = {&p};
    hipError_t e = hipLaunchCooperativeKernel((const void*)fwd_kernel, dim3(grid), dim3(NTHREADS), args, LDS_BYTES, stream);
    if (e != hipSuccess) fprintf(stderr, "cooperative launch failed: %s (grid %d)\n", hipGetErrorString(e), grid);
#else
    for (int ph = 0; ph < NPH; ++ph) { p.ph_lo = ph; p.ph_hi = ph + 1; hipLaunchKernelGGL(fwd_kernel, dim3(grid), dim3(NTHREADS), LDS_BYTES, stream, p); }
#endif
}
```

```cpp
#include <hip/hip_runtime.h>
#include <hip/hip_cooperative_groups.h>
#include <cstdio>
#include <cstdint>
namespace cg = cooperative_groups;

#ifndef MK_N_LAUNCHES
#define MK_N_LAUNCHES 1
#endif

#define LAS __attribute__((address_space(3)))
typedef unsigned short bf16_t;
typedef short bf16x8 __attribute__((ext_vector_type(8)));
typedef short bf16x4 __attribute__((ext_vector_type(4)));
typedef float f32x2 __attribute__((ext_vector_type(2)));
typedef float f32x4 __attribute__((ext_vector_type(4)));
typedef float f32x16 __attribute__((ext_vector_type(16)));
typedef unsigned u32x2 __attribute__((ext_vector_type(2)));
typedef unsigned u32x4 __attribute__((ext_vector_type(4)));

constexpr int BATCH = 2, SEQ = 8192, M = BATCH * SEQ, D = 1024, DIN = 3328, DFF = 2816;
constexpr float EPS = 1e-6f;
constexpr float C2 = 0.125f * 1.4426950408889634f;
constexpr int NPH = 8;
constexpr int NTHREADS = 512, NWAVES = 8;
constexpr int LDS_BYTES = 147456;

constexpr size_t MiB = 1u << 20;
constexpr size_t WS_CTL = 0, CTL_ZERO_BYTES = 1 * MiB;
constexpr size_t CTL_SSATT = 64 * 1024, CTL_SS2 = 128 * 1024, CTL_SS3 = 192 * 1024, CTL_LB = 256 * 1024;
constexpr size_t WS_WIN = 1 * MiB, WS_WOUT = 8 * MiB, WS_WGU = 10 * MiB, WS_WDN = 21 * MiB;
constexpr size_t WS_XN = 27 * MiB;
constexpr size_t WS_QH = 59 * MiB;
constexpr size_t WS_IV = 75 * MiB;
constexpr size_t WS_GH = 91 * MiB;
constexpr size_t WS_ZF = 107 * MiB;
constexpr size_t WS_AQKV = 171 * MiB;
constexpr size_t WS_MIX = 171 * MiB;
constexpr size_t WS_QA = 219 * MiB;
constexpr size_t WS_KA = 235 * MiB;
constexpr size_t WS_VA = 239 * MiB;
constexpr size_t WS_VT = 243 * MiB;
constexpr size_t WS_XB = 59 * MiB;
constexpr size_t WS_H = 91 * MiB;
constexpr size_t WS_END = 256 * MiB;
static_assert(WS_WDN + (size_t)D * DFF * 2 <= WS_XN && WS_H + (size_t)M * DFF * 2 <= WS_QA && WS_VT + (size_t)4 * 64 * SEQ * 2 <= WS_END, "ws map");

struct Params {
    const float* x; const float* norm1_w; const float* w_in; const float* lb_logits; const float* hg_norm_w; const float* q_norm_w; const float* k_norm_w;
    const float* att_norm_w; const float* w_out; const float* norm2_w; const float* w_gate_up; const float* w_down; const float* final_norm_w;
    float* out; unsigned char* ws; int ph_lo, ph_hi;
};

__device__ __forceinline__ unsigned f2bf(float f) { unsigned u = __builtin_bit_cast(unsigned, f); return (u + 0x7fffu + ((u >> 16) & 1u)) >> 16; }
__device__ __forceinline__ unsigned pk2(float lo, float hi) { return f2bf(lo) | (f2bf(hi) << 16); }
__device__ __forceinline__ float bf2f(bf16_t b) { return __builtin_bit_cast(float, (unsigned)b << 16); }
__device__ __forceinline__ float silu_f(float v) { return v * __builtin_amdgcn_rcpf(1.f + __builtin_amdgcn_exp2f(-1.4426950408889634f * v)); }
__device__ __forceinline__ float sigmoid_f(float v) { return __builtin_amdgcn_rcpf(1.f + __builtin_amdgcn_exp2f(-1.4426950408889634f * v)); }
__device__ __forceinline__ int crow(int r, int hi) { return (r & 3) + 8 * (r >> 2) + 4 * hi; }
__device__ __forceinline__ float wave_sum(float v) {
#pragma unroll
    for (int o = 1; o < 64; o <<= 1) v += __shfl_xor(v, o);
    return v;
}

namespace pg8 {
#define PG8_LAS __attribute__((address_space(3)))
typedef unsigned short bf16_t;
typedef short bf16x8 __attribute__((ext_vector_type(8)));
typedef float f32x4 __attribute__((ext_vector_type(4)));
typedef unsigned u32x4 __attribute__((ext_vector_type(4)));
constexpr int BM = 256, BK = 64, HALF = 128, HTB = HALF * BK * 2  , STAGE_BYTES = 8 * HTB, NXCD = 8, WGM = 8;

__host__ __device__ __forceinline__ int lds_byte(int r, int c) { const int st = (r >> 4) * 2 + (c >> 5), rr = r & 15, cc = c & 31, ob = rr * 64 + cc * 2; return st * 1024 + (ob ^ (((ob >> 9) & 1) << 5)); }
__host__ __device__ __forceinline__ void stage_rc(int b, int& R, int& C) { const int st = b / 1024, sb = b % 1024, swz = sb ^ (((sb >> 9) & 1) << 5); R = (st >> 1) * 16 + swz / 64; C = (st & 1) * 32 + (swz % 64) / 2; }
__host__ __device__ __forceinline__ int perm32(int rho) { const int n = rho >> 4, i = rho & 15; return 8 * (i >> 2) + 4 * n + (i & 3); }

struct Unit { int pm, pn; };
struct Gemm { const bf16_t* A; const bf16_t* Bt; int M, N, K; };

struct StaticOrder {
    int nM, nN, nwg, G, c;
    __host__ __device__ void init(int M, int N, int G_, int c_) { nM = M / BM; nN = N / BM; nwg = nM * nN; G = G_; c = c_; }
    __host__ __device__ bool next(int i, Unit& u) const {
        const long L = (long)i * G + c; if (L >= nwg) return false;
        int wgid = (int)L; { const int q = nwg / NXCD, r = nwg % NXCD, xcd = wgid % NXCD, off = wgid / NXCD; wgid = (xcd < r ? xcd * (q + 1) : r * (q + 1) + (xcd - r) * q) + off; }
        const int nig = WGM * nN, gid = wgid / nig, fm = gid * WGM, gsz = (nM - fm) < WGM ? (nM - fm) : WGM;
        u.pm = fm + ((wgid % nig) % gsz); u.pn = (wgid % nig) / gsz; return true;
    }
    __device__ __forceinline__ void a_ready(const Unit&) const {}
    __device__ __forceinline__ void done(const Unit&) const {}
};

__device__ __forceinline__ unsigned cvt_pk_bf16(float lo, float hi) { unsigned r; asm volatile("v_cvt_pk_bf16_f32 %0, %1, %2" : "=v"(r) : "v"(lo), "v"(hi)); return r; }
typedef float f32x2 __attribute__((ext_vector_type(2)));
__device__ __forceinline__ f32x4 silu4(f32x4 v) { f32x4 o; o.x = silu_f(v.x); o.y = silu_f(v.y); o.z = silu_f(v.z); o.w = silu_f(v.w); return o; }
struct PgEpiIn {
    static constexpr bool PERM = true, AFTER_DRAIN = false, MID = false; static constexpr int MID_T = 0;
    bf16_t* QH; float* ZF; bf16_t* IV; bf16_t* GH; float* AQKV; const float* LB;
    __device__ __forceinline__ void mid(f32x4 (&)[2][2][4][2], const Unit&, int, int) const {}
    __device__ __forceinline__ void operator()(const f32x4 (&acc)[2][2][4][2], const Unit& u, int wr, int wc, int fr, int fq) const {
        const int row0 = u.pm * BM + wr * 64 + fr, pn = u.pn, cw = wc * 32 + 8 * fq;
        if (pn < 2 || (pn >= 6 && pn < 10)) {
            bf16_t* base; int colt; bool act;
            if (pn < 2) { base = QH; colt = pn * 256; act = true; } else if (pn < 8) { base = IV; colt = (pn - 6) * 256; act = false; } else { base = GH; colt = (pn - 8) * 256; act = true; }
#pragma unroll
            for (int ai = 0; ai < 2; ++ai)
#pragma unroll
                for (int m = 0; m < 4; ++m) { bf16_t* rowp = base + (size_t)(row0 + ai * HALF + m * 16) * 512 + colt + cw;
#pragma unroll
                    for (int bj = 0; bj < 2; ++bj) { f32x4 v0 = acc[ai][bj][m][0], v1 = acc[ai][bj][m][1]; if (act) { v0 = silu4(v0); v1 = silu4(v1); }
                        u32x4 w; w.x = cvt_pk_bf16(v0[0], v0[1]); w.y = cvt_pk_bf16(v0[2], v0[3]); w.z = cvt_pk_bf16(v1[0], v1[1]); w.w = cvt_pk_bf16(v1[2], v1[3]);
                        *(u32x4*)(rowp + bj * HALF) = w; } }
        } else if (pn < 6) {
            const int colt = (pn - 2) * 256; f32x4 lb[2][2];
#pragma unroll
            for (int bj = 0; bj < 2; ++bj)
#pragma unroll
                for (int n = 0; n < 2; ++n) lb[bj][n] = *(const f32x4*)(LB + colt + bj * HALF + cw + 4 * n);
#pragma unroll
            for (int ai = 0; ai < 2; ++ai)
#pragma unroll
                for (int m = 0; m < 4; ++m) { float* rowp = ZF + (size_t)(row0 + ai * HALF + m * 16) * 1024 + colt + cw;
#pragma unroll
                    for (int bj = 0; bj < 2; ++bj)
#pragma unroll
                        for (int n = 0; n < 2; ++n) { const f32x4 v = acc[ai][bj][m][n], l = lb[bj][n]; f32x4 f;
                            f.x = l.x + (1.f - l.x) * sigmoid_f(v.x); f.y = l.y + (1.f - l.y) * sigmoid_f(v.y); f.z = l.z + (1.f - l.z) * sigmoid_f(v.z); f.w = l.w + (1.f - l.w) * sigmoid_f(v.w);
                            *(f32x4*)(rowp + bj * HALF + 4 * n) = f; } }
        } else {
            const int colt = (pn - 10) * 256;
#pragma unroll
            for (int ai = 0; ai < 2; ++ai)
#pragma unroll
                for (int m = 0; m < 4; ++m) { float* rowp = AQKV + (size_t)(row0 + ai * HALF + m * 16) * 768 + colt + cw;
#pragma unroll
                    for (int bj = 0; bj < 2; ++bj)
#pragma unroll
                        for (int n = 0; n < 2; ++n) *(f32x4*)(rowp + bj * HALF + 4 * n) = acc[ai][bj][m][n]; }
        }
    }
};
struct PgEpiOut {
    static constexpr bool PERM = true, AFTER_DRAIN = false, MID = true; static constexpr int MID_T = 8;
    const float* x; float* out; bf16_t* XB; float* ss2; const float* ssatt;
    __device__ __forceinline__ void mid(f32x4 (&acc)[2][2][4][2], const Unit& u, int wr, int fr) const {
#pragma unroll
        for (int ai = 0; ai < 2; ++ai)
#pragma unroll
            for (int m = 0; m < 4; ++m) { const float s = 1.f / sqrtf(ssatt[u.pm * BM + ai * HALF + wr * 64 + m * 16 + fr] * (1.f / 512.f) + EPS);
#pragma unroll
                for (int bj = 0; bj < 2; ++bj)
#pragma unroll
                    for (int n = 0; n < 2; ++n) acc[ai][bj][m][n] *= s; }
    }
    __device__ __forceinline__ void operator()(const f32x4 (&acc)[2][2][4][2], const Unit& u, int wr, int wc, int fr, int fq) const {
#pragma unroll
        for (int ai = 0; ai < 2; ++ai)
#pragma unroll
            for (int m = 0; m < 4; ++m) { const int row = u.pm * BM + ai * HALF + wr * 64 + m * 16 + fr; float q = 0.f;
#pragma unroll
                for (int bj = 0; bj < 2; ++bj) { const size_t idx = (size_t)row * D + u.pn * BM + bj * HALF + wc * 32 + 8 * fq;
                    const f32x4 v0 = *(const f32x4*)(x + idx) + acc[ai][bj][m][0], v1 = *(const f32x4*)(x + idx + 4) + acc[ai][bj][m][1];
                    *(f32x4*)(out + idx) = v0; *(f32x4*)(out + idx + 4) = v1;
                    u32x4 w; w.x = cvt_pk_bf16(v0[0], v0[1]); w.y = cvt_pk_bf16(v0[2], v0[3]); w.z = cvt_pk_bf16(v1[0], v1[1]); w.w = cvt_pk_bf16(v1[2], v1[3]);
                    *(u32x4*)(XB + idx) = w;
                    q += (v0[0] * v0[0] + v0[1] * v0[1]) + (v0[2] * v0[2] + v0[3] * v0[3]) + (v1[0] * v1[0] + v1[1] * v1[1]) + (v1[2] * v1[2] + v1[3] * v1[3]); }
                q += __shfl_xor(q, 16); q += __shfl_xor(q, 32);
                if (fq == 0) atomicAdd(ss2 + row, q); }
    }
};
struct PgEpiGU {
    static constexpr bool PERM = true, AFTER_DRAIN = false, MID = false; static constexpr int MID_T = 0;
    bf16_t* H; const float* ss2;
    __device__ __forceinline__ void mid(f32x4 (&)[2][2][4][2], const Unit&, int, int) const {}
    __device__ __forceinline__ void operator()(const f32x4 (&acc)[2][2][4][2], const Unit& u, int wr, int wc, int fr, int fq) const {
#pragma unroll
        for (int ai = 0; ai < 2; ++ai)
#pragma unroll
            for (int m = 0; m < 4; ++m) { const int row = u.pm * BM + ai * HALF + wr * 64 + m * 16 + fr; const float s = 1.f / sqrtf(ss2[row] * (1.f / D) + EPS);
                const f32x4 a0 = silu4(acc[ai][0][m][0] * s) * (acc[ai][1][m][0] * s), a1 = silu4(acc[ai][0][m][1] * s) * (acc[ai][1][m][1] * s);
                u32x4 w; w.x = cvt_pk_bf16(a0[0], a0[1]); w.y = cvt_pk_bf16(a0[2], a0[3]); w.z = cvt_pk_bf16(a1[0], a1[1]); w.w = cvt_pk_bf16(a1[2], a1[3]);
                *(u32x4*)(H + (size_t)row * DFF + 128 * u.pn + wc * 32 + 8 * fq) = w; }
    }
};
struct PgEpiDown {
    static constexpr bool PERM = true, AFTER_DRAIN = false, MID = false; static constexpr int MID_T = 0;
    float* out; float* ss3;
    __device__ __forceinline__ void mid(f32x4 (&)[2][2][4][2], const Unit&, int, int) const {}
    __device__ __forceinline__ void operator()(const f32x4 (&acc)[2][2][4][2], const Unit& u, int wr, int wc, int fr, int fq) const {
#pragma unroll
        for (int ai = 0; ai < 2; ++ai)
#pragma unroll
            for (int m = 0; m < 4; ++m) { const int row = u.pm * BM + ai * HALF + wr * 64 + m * 16 + fr; float q = 0.f;
#pragma unroll
                for (int bj = 0; bj < 2; ++bj) { const size_t idx = (size_t)row * D + u.pn * BM + bj * HALF + wc * 32 + 8 * fq;
                    const f32x4 v0 = *(const f32x4*)(out + idx) + acc[ai][bj][m][0], v1 = *(const f32x4*)(out + idx + 4) + acc[ai][bj][m][1];
                    *(f32x4*)(out + idx) = v0; *(f32x4*)(out + idx + 4) = v1;
                    q += (v0[0] * v0[0] + v0[1] * v0[1]) + (v0[2] * v0[2] + v0[3] * v0[3]) + (v1[0] * v1[0] + v1[1] * v1[1]) + (v1[2] * v1[2] + v1[3] * v1[3]); }
                q += __shfl_xor(q, 16); q += __shfl_xor(q, 32);
                if (fq == 0) atomicAdd(ss3 + row, q); }
    }
};
template <class Epi, class Sched, bool ALIGN_EPI = false, bool SP2 = false>
__device__ __forceinline__ void gemm_phase(PG8_LAS unsigned char* lds, const Gemm g, const Sched& S, const Epi& E) {
    const int tid = threadIdx.x, wid = __builtin_amdgcn_readfirstlane(tid >> 6), lane = tid & 63, wr = wid >> 2, wc = wid & 3, fr = lane & 15, fq = lane >> 4;
    const int K = g.K, nt = K / BK;
    unsigned voffA[2], voffB[2];
#pragma unroll
    for (int i = 0; i < 2; ++i) { int R, C; stage_rc(tid * 16 + i * 8192, R, C); const int Rb = Epi::PERM ? ((R & ~31) + perm32(R & 31)) : R;
        voffA[i] = (unsigned)(R * K + C) * 2u; voffB[i] = (unsigned)(Rb * K + C) * 2u; }
    const size_t kstep = (size_t)(BK * 2);
    const size_t hstep = (size_t)HALF * K * 2;
    const size_t tstep = 2 * hstep;
    const unsigned ldsw = (unsigned)wid * 1024u;
    const int aoff = lds_byte(wr * 64 + fr, fq * 8), boff = lds_byte(wc * 32 + fr, fq * 8);
#define PG8_SA(b, h) (((b) * 2 + (h)) * HTB)
#define PG8_SB(b, h) ((4 + (b) * 2 + (h)) * HTB)
#define PG8_STAGE(bufoff, gbase, voff) do { _Pragma("unroll") for (int _i = 0; _i < 2; ++_i) \
        __builtin_amdgcn_global_load_lds((const unsigned*)((const char*)(gbase) + (voff)[_i]), (PG8_LAS unsigned*)(lds + (bufoff) + ldsw + _i * 8192), 16, 0, 0); } while (0)
#define PG8_LDA(dst, b, h) do { _Pragma("unroll") for (int m = 0; m < 4; ++m) _Pragma("unroll") for (int k = 0; k < 2; ++k) dst[m][k] = *(const PG8_LAS bf16x8*)(lds + PG8_SA(b, h) + aoff + m * 2048 + k * 1024); } while (0)
#define PG8_LDB(dst, b, h) do { _Pragma("unroll") for (int n = 0; n < 2; ++n) _Pragma("unroll") for (int k = 0; k < 2; ++k) dst[n][k] = *(const PG8_LAS bf16x8*)(lds + PG8_SB(b, h) + boff + n * 2048 + k * 1024); } while (0)
#define PG8_MMA(ai, bj, At, Bt) do { __builtin_amdgcn_s_setprio(1); _Pragma("unroll") for (int m = 0; m < 4; ++m) _Pragma("unroll") for (int n = 0; n < 2; ++n) _Pragma("unroll") for (int k = 0; k < 2; ++k) \
        acc[ai][bj][m][n] = __builtin_amdgcn_mfma_f32_16x16x32_bf16(Bt[n][k], At[m][k], acc[ai][bj][m][n], 0, 0, 0); __builtin_amdgcn_s_setprio(0); } while (0)
#define PG8_WAIT_V(n) asm volatile("s_waitcnt vmcnt(" #n ")" ::: "memory")
#define PG8_WAIT_L(n) asm volatile("s_waitcnt lgkmcnt(" #n ")" ::: "memory")
#define PG8_BAR __builtin_amdgcn_s_barrier()
#define PG8_SCHED __builtin_amdgcn_sched_barrier(0)
    Unit cur, nxt; int ui = 0;
    if (!S.next(0, cur)) return;
    f32x4 acc[2][2][4][2];
#pragma unroll
    for (int a = 0; a < 2; ++a)
#pragma unroll
        for (int b = 0; b < 2; ++b)
#pragma unroll
            for (int m = 0; m < 4; ++m)
#pragma unroll
                for (int n = 0; n < 2; ++n) acc[a][b][m][n] = (f32x4){0.f, 0.f, 0.f, 0.f};
    bf16x8 At[4][2], B0[2][2], B1[2][2];
    const char* cA = (const char*)g.A + (size_t)cur.pm * tstep; const char* cB = (const char*)g.Bt + (size_t)cur.pn * tstep;
    S.a_ready(cur);
    if constexpr (SP2) {
        PG8_STAGE(PG8_SB(0, 0), cB, voffB); PG8_STAGE(PG8_SB(0, 1), cB + hstep, voffB); PG8_STAGE(PG8_SA(0, 0), cA, voffA); PG8_STAGE(PG8_SA(0, 1), cA + hstep, voffA);
        if (wr == 1) PG8_BAR;
        PG8_WAIT_V(2); PG8_BAR;
        PG8_STAGE(PG8_SB(1, 0), cB + kstep, voffB); PG8_STAGE(PG8_SA(1, 0), cA + kstep, voffA); PG8_STAGE(PG8_SB(1, 1), cB + hstep + kstep, voffB);
        PG8_WAIT_V(6); PG8_BAR;
    } else {
        PG8_STAGE(PG8_SB(0, 0), cB, voffB); PG8_STAGE(PG8_SA(0, 0), cA, voffA); PG8_STAGE(PG8_SB(0, 1), cB + hstep, voffB); PG8_STAGE(PG8_SA(0, 1), cA + hstep, voffA);
        if (wr == 1) PG8_BAR;
        PG8_WAIT_V(4); PG8_BAR;
        PG8_STAGE(PG8_SB(1, 0), cB + kstep, voffB); PG8_STAGE(PG8_SA(1, 0), cA + kstep, voffA); PG8_STAGE(PG8_SB(1, 1), cB + hstep + kstep, voffB);
        PG8_WAIT_V(6); PG8_BAR;
    }
    for (;;) {
        const bool has_next = S.next(ui + 1, nxt);
        const char* nA = has_next ? (const char*)g.A + (size_t)nxt.pm * tstep : cA; const char* nB = has_next ? (const char*)g.Bt + (size_t)nxt.pn * tstep : cB;
        for (int t = 0; t < nt; t += 2) {
            const bool last = (t == nt - 2);
            if constexpr (Epi::MID) { if (t == Epi::MID_T) E.mid(acc, cur, wr, fr); }
            const char* a1 = cA + (size_t)(t + 1) * kstep;
            const char* a2 = last ? nA : cA + (size_t)(t + 2) * kstep; const char* b2 = last ? nB : cB + (size_t)(t + 2) * kstep;
            const char* a3 = a2 + kstep; const char* b3 = b2 + kstep;
            if (last && has_next) S.a_ready(nxt);
            if constexpr (SP2) {
            PG8_LDB(B0, 0, 0); PG8_LDB(B1, 0, 1); PG8_SCHED; PG8_LDA(At, 0, 0); PG8_STAGE(PG8_SA(1, 1), a1 + hstep, voffA);
            PG8_WAIT_V(8); PG8_WAIT_L(0); PG8_BAR; PG8_MMA(0, 0, At, B0); PG8_MMA(0, 1, At, B1); PG8_BAR; PG8_SCHED;
            PG8_LDA(At, 0, 1); PG8_STAGE(PG8_SB(0, 0), b2, voffB); PG8_STAGE(PG8_SB(0, 1), b2 + hstep, voffB); PG8_STAGE(PG8_SA(0, 0), a2, voffA);
            PG8_WAIT_V(8); PG8_WAIT_L(0); PG8_BAR; PG8_MMA(1, 0, At, B0); PG8_MMA(1, 1, At, B1); PG8_BAR; PG8_SCHED;
            PG8_LDB(B0, 1, 0); PG8_LDB(B1, 1, 1); PG8_SCHED; PG8_LDA(At, 1, 0); PG8_STAGE(PG8_SA(0, 1), a2 + hstep, voffA);
            PG8_WAIT_V(8); PG8_WAIT_L(0); PG8_BAR; PG8_MMA(0, 0, At, B0); PG8_MMA(0, 1, At, B1); PG8_BAR; PG8_SCHED;
            PG8_LDA(At, 1, 1); PG8_STAGE(PG8_SB(1, 0), b3, voffB); PG8_STAGE(PG8_SB(1, 1), b3 + hstep, voffB); PG8_STAGE(PG8_SA(1, 0), a3, voffA);
            PG8_WAIT_V(8); PG8_WAIT_L(0); PG8_BAR; PG8_MMA(1, 0, At, B0); PG8_MMA(1, 1, At, B1); PG8_BAR; PG8_SCHED;
            } else {
            PG8_LDB(B0, 0, 0); PG8_SCHED; PG8_LDA(At, 0, 0); PG8_STAGE(PG8_SA(1, 1), a1 + hstep, voffA);
            PG8_WAIT_L(8); PG8_BAR; PG8_WAIT_L(0); PG8_MMA(0, 0, At, B0); PG8_BAR; PG8_SCHED;
            PG8_LDB(B1, 0, 1); PG8_STAGE(PG8_SB(0, 0), b2, voffB);
            PG8_BAR; PG8_WAIT_L(0); PG8_MMA(0, 1, At, B1); PG8_BAR;
            PG8_LDA(At, 0, 1); PG8_STAGE(PG8_SA(0, 0), a2, voffA);
            PG8_BAR; PG8_WAIT_L(0); PG8_MMA(1, 0, At, B0); PG8_BAR; PG8_SCHED;
            PG8_STAGE(PG8_SB(0, 1), b2 + hstep, voffB);
            PG8_WAIT_V(6); PG8_BAR; PG8_MMA(1, 1, At, B1); PG8_BAR;
            PG8_LDB(B0, 1, 0); PG8_SCHED; PG8_LDA(At, 1, 0); PG8_STAGE(PG8_SA(0, 1), a2 + hstep, voffA);
            PG8_WAIT_L(8); PG8_BAR; PG8_WAIT_L(0); PG8_MMA(0, 0, At, B0); PG8_BAR; PG8_SCHED;
            PG8_LDB(B1, 1, 1); PG8_STAGE(PG8_SB(1, 0), b3, voffB);
            PG8_BAR; PG8_WAIT_L(0); PG8_MMA(0, 1, At, B1); PG8_BAR;
            PG8_LDA(At, 1, 1); PG8_STAGE(PG8_SA(1, 0), a3, voffA);
            PG8_BAR; PG8_WAIT_L(0); PG8_MMA(1, 0, At, B0); PG8_BAR; PG8_SCHED;
            PG8_STAGE(PG8_SB(1, 1), b3 + hstep, voffB);
            PG8_WAIT_V(6); PG8_BAR; PG8_MMA(1, 1, At, B1); PG8_BAR;
            }
        }
        if constexpr (ALIGN_EPI) { if (wr == 0) PG8_BAR; }
        if constexpr (!Epi::AFTER_DRAIN) { E(acc, cur, wr, wc, fr, fq); S.done(cur); }
        if (!has_next) break;
#pragma unroll
        for (int a = 0; a < 2; ++a)
#pragma unroll
            for (int b = 0; b < 2; ++b)
#pragma unroll
                for (int m = 0; m < 4; ++m)
#pragma unroll
                    for (int n = 0; n < 2; ++n) acc[a][b][m][n] = (f32x4){0.f, 0.f, 0.f, 0.f};
        cur = nxt; cA = nA; cB = nB; ++ui;
        if constexpr (ALIGN_EPI) { if (wr == 1) PG8_BAR; }
    }
    PG8_WAIT_V(0);
    if constexpr (!ALIGN_EPI) { if (wr == 0) PG8_BAR; }
    PG8_BAR;
    if constexpr (Epi::AFTER_DRAIN) { E.fused(acc, cur, wr, wc, fr, fq, lds, wid, lane); S.done(cur); }
#undef PG8_SA
#undef PG8_SB
#undef PG8_STAGE
#undef PG8_LDA
#undef PG8_LDB
#undef PG8_MMA
#undef PG8_WAIT_V
#undef PG8_WAIT_L
#undef PG8_BAR
#undef PG8_SCHED
}
}

__device__ __forceinline__ void transpose_item(const float* W, int N, bf16_t* WT, int Kd, int k_src0, int k_dst0, int n_src0, int n_dst0, const float* sc, LAS float* scr, int lane) {
#pragma unroll 8
    for (int i = 0; i < 32; ++i) { const int kk = 2 * i + (lane >> 5); float v = W[(size_t)(k_src0 + kk) * N + n_src0 + (lane & 31)]; if (sc) v *= sc[k_src0 + kk]; scr[kk * 33 + (lane & 31)] = v; }
    asm volatile("s_waitcnt lgkmcnt(0)" ::: "memory");
    const int c = lane & 7;
#pragma unroll
    for (int j = 0; j < 4; ++j) { const int n = (lane >> 3) + 8 * j; const LAS float* s = scr + (8 * c) * 33 + n;
        u32x4 o; o.x = pk2(s[0 * 33], s[1 * 33]); o.y = pk2(s[2 * 33], s[3 * 33]); o.z = pk2(s[4 * 33], s[5 * 33]); o.w = pk2(s[6 * 33], s[7 * 33]);
        *(u32x4*)(WT + (size_t)(n_dst0 + n) * Kd + k_dst0 + 8 * c) = o; }
    asm volatile("s_waitcnt lgkmcnt(0)" ::: "memory");
}

__device__ __forceinline__ void p0_prologue(const Params& p, LAS unsigned char* lds, int bid, int nb) {
    const int tid = threadIdx.x, lane = tid & 63, wave = tid >> 6;
    LAS float* scr = (LAS float*)(lds + wave * 16384);
    const int gw = bid * NWAVES + wave, NGW = nb * NWAVES;
    bf16_t* Win_t = (bf16_t*)(p.ws + WS_WIN); bf16_t* Wout_t = (bf16_t*)(p.ws + WS_WOUT); bf16_t* Wgu_t = (bf16_t*)(p.ws + WS_WGU); bf16_t* Wdn_t = (bf16_t*)(p.ws + WS_WDN);
    constexpr int I_IN = (D / 64) * (DIN / 32), I_OUT = (D / 64) * (D / 32), I_GU = (D / 64) * (2 * DFF / 32), I_DN = (DFF / 64) * (D / 32);
    constexpr int NITEMS = I_IN + I_OUT + I_GU + I_DN;
    for (int it = gw; it < NITEMS; it += NGW) {
        int r = it;
        if (r < I_IN) { const int nblk = DIN / 32, kb = r / nblk, nbk = r % nblk; transpose_item(p.w_in, DIN, Win_t, D, 64 * kb, 64 * kb, 32 * nbk, 32 * nbk, nullptr, scr, lane); continue; } r -= I_IN;
        if (r < I_OUT) { const int nblk = D / 32, kb = r / nblk, nbk = r % nblk; const int ks = 64 * kb;
            transpose_item(p.w_out, D, Wout_t, D, ks, (ks + 512) & 1023, 32 * nbk, 32 * nbk, ks >= 512 ? p.att_norm_w - 512 : nullptr, scr, lane); continue; } r -= I_OUT;
        if (r < I_GU) { const int nblk = 2 * DFF / 32, kb = r / nblk, nbk = r % nblk; const int nd = 32 * nbk, pn = nd >> 8, nn = nd & 255;
            const int ns = nn < 128 ? 128 * pn + nn : DFF + 128 * pn + nn - 128;
            transpose_item(p.w_gate_up, 2 * DFF, Wgu_t, D, 64 * kb, 64 * kb, ns, nd, p.norm2_w, scr, lane); continue; } r -= I_GU;
        { const int nblk = D / 32, kb = r / nblk, nbk = r % nblk; transpose_item(p.w_down, D, Wdn_t, DFF, 64 * kb, 64 * kb, 32 * nbk, 32 * nbk, nullptr, scr, lane); }
    }
    bf16_t* XN = (bf16_t*)(p.ws + WS_XN);
    for (int m = gw; m < M; m += NGW) {
        const f32x4* xr = (const f32x4*)(p.x + (size_t)m * D) + lane; const f32x4* wr = (const f32x4*)p.norm1_w + lane;
        f32x4 v[4]; float s = 0.f;
#pragma unroll
        for (int j = 0; j < 4; ++j) { v[j] = xr[64 * j]; s += (v[j].x * v[j].x + v[j].y * v[j].y) + (v[j].z * v[j].z + v[j].w * v[j].w); }
        const float rstd = 1.f / sqrtf(wave_sum(s) * (1.f / D) + EPS);
        unsigned long long* o8 = (unsigned long long*)(XN + (size_t)m * D) + lane;
#pragma unroll
        for (int j = 0; j < 4; ++j) { const f32x4 w = wr[64 * j]; o8[64 * j] = (unsigned long long)pk2(v[j].x * rstd * w.x, v[j].y * rstd * w.y) | ((unsigned long long)pk2(v[j].z * rstd * w.z, v[j].w * rstd * w.w) << 32); }
    }
    if (bid == 0) { float* LB = (float*)(p.ws + WS_CTL + CTL_LB);
        for (int j = tid; j < 1024; j += NTHREADS) { const int d = j >> 9, jj = j & 511; const float a0 = p.lb_logits[d * 1024 + jj], a1 = p.lb_logits[d * 1024 + 512 + jj]; LB[j] = 1.f / (1.f + expf(a1 - a0)); } }
}

struct EpiIn {
    static constexpr bool PAIR = false, MID = false;
    bf16_t* QH; float* ZF; bf16_t* IV; bf16_t* GH; float* AQKV; const float* LB;
    __device__ __forceinline__ void elem(int row, int col, float v) const {
        if (col < 512) QH[(size_t)row * 512 + col] = (bf16_t)f2bf(silu_f(v));
        else if (col < 1536) { const int c = col - 512; const float lb = LB[c]; ZF[(size_t)row * 1024 + c] = lb + (1.f - lb) * sigmoid_f(v); }
        else if (col < 2048) IV[(size_t)row * 512 + col - 1536] = (bf16_t)f2bf(v);
        else if (col < 2560) GH[(size_t)row * 512 + col - 2048] = (bf16_t)f2bf(silu_f(v));
        else AQKV[(size_t)row * 768 + col - 2560] = v;
    }
    __device__ __forceinline__ void naive(f32x16 (&acc)[2][2], int row0, int col0, int cs, int r32, int hi) const {
#pragma unroll
        for (int i = 0; i < 2; ++i)
#pragma unroll
            for (int j = 0; j < 2; ++j)
#pragma unroll
                for (int r = 0; r < 16; ++r) elem(row0 + 32 * i + crow(r, hi), col0 + j * cs + r32, acc[i][j][r]);
    }
    __device__ __forceinline__ void mid(f32x16 (&)[2][2], int, int, int) const {}
};
struct EpiOut {
    static constexpr bool PAIR = false, MID = true; static constexpr int MIDK = 512;
    const float* x; float* out; bf16_t* XB; float* ss2; const float* ssatt;
    __device__ __forceinline__ void mid(f32x16 (&acc)[2][2], int row0, int r32, int hi) const {
#pragma unroll
        for (int i = 0; i < 2; ++i)
#pragma unroll
            for (int r = 0; r < 16; ++r) { const float s = 1.f / sqrtf(ssatt[row0 + 32 * i + crow(r, hi)] * (1.f / 512.f) + EPS); acc[i][0][r] *= s; acc[i][1][r] *= s; }
    }
    __device__ __forceinline__ void naive(f32x16 (&acc)[2][2], int row0, int col0, int cs, int r32, int hi) const {
#pragma unroll
        for (int i = 0; i < 2; ++i)
#pragma unroll
            for (int r = 0; r < 16; ++r) { const int row = row0 + 32 * i + crow(r, hi); float q = 0.f;
#pragma unroll
                for (int j = 0; j < 2; ++j) { const size_t idx = (size_t)row * D + col0 + j * cs + r32; const float v = x[idx] + acc[i][j][r]; out[idx] = v; XB[idx] = (bf16_t)f2bf(v); q += v * v; }
#pragma unroll
                for (int o = 1; o < 32; o <<= 1) q += __shfl_xor(q, o);
                if (r32 == 0) atomicAdd(ss2 + row, q); }
    }
};
struct EpiGU {
    static constexpr bool PAIR = true, MID = false;
    bf16_t* H; const float* ss2;
    __device__ __forceinline__ void naive(f32x16 (&acc)[2][2], int row0, int col0, int cs, int r32, int hi) const {
        const int pn = col0 >> 8, cc = (col0 & 255) + r32;
#pragma unroll
        for (int i = 0; i < 2; ++i)
#pragma unroll
            for (int r = 0; r < 16; ++r) { const int row = row0 + 32 * i + crow(r, hi); const float s = 1.f / sqrtf(ss2[row] * (1.f / D) + EPS);
                H[(size_t)row * DFF + 128 * pn + cc] = (bf16_t)f2bf(silu_f(acc[i][0][r] * s) * (acc[i][1][r] * s)); }
    }
    __device__ __forceinline__ void mid(f32x16 (&)[2][2], int, int, int) const {}
};
struct EpiDown {
    static constexpr bool PAIR = false, MID = false;
    float* out; float* ss3;
    __device__ __forceinline__ void naive(f32x16 (&acc)[2][2], int row0, int col0, int cs, int r32, int hi) const {
#pragma unroll
        for (int i = 0; i < 2; ++i)
#pragma unroll
            for (int r = 0; r < 16; ++r) { const int row = row0 + 32 * i + crow(r, hi); float q = 0.f;
#pragma unroll
                for (int j = 0; j < 2; ++j) { const size_t idx = (size_t)row * D + col0 + j * cs + r32; const float v = out[idx] + acc[i][j][r]; out[idx] = v; q += v * v; }
#pragma unroll
                for (int o = 1; o < 32; o <<= 1) q += __shfl_xor(q, o);
                if (r32 == 0) atomicAdd(ss3 + row, q); }
    }
    __device__ __forceinline__ void mid(f32x16 (&)[2][2], int, int, int) const {}
};

template <class Epi>
__device__ __forceinline__ void ngemm_phase(const bf16_t* A, const bf16_t* Bt, int M_, int N_, int K_, const Epi& E, int bid, int nb) {
    const int tid = threadIdx.x, lane = tid & 63, wid = tid >> 6, r32 = lane & 31, hi = lane >> 5, wr = wid >> 2, wc = wid & 3;
    const int nM = M_ / 128, nN = N_ / 256; constexpr int CS = Epi::PAIR ? 128 : 32;
    for (int u = bid; u < nM * nN; u += nb) {
        const int pm = u / nN, pn = u % nN;
        const int row0 = pm * 128 + wr * 64, col0 = pn * 256 + (Epi::PAIR ? wc * 32 : wc * 64);
        f32x16 acc[2][2];
#pragma unroll
        for (int i = 0; i < 2; ++i)
#pragma unroll
            for (int j = 0; j < 2; ++j)
#pragma unroll
                for (int r = 0; r < 16; ++r) acc[i][j][r] = 0.f;
        const bf16_t* a0 = A + (size_t)(row0 + r32) * K_ + hi * 8; const bf16_t* a1 = a0 + (size_t)32 * K_;
        const bf16_t* b0 = Bt + (size_t)(col0 + r32) * K_ + hi * 8; const bf16_t* b1 = b0 + (size_t)CS * K_;
        for (int k = 0; k < K_; k += 16) {
            if constexpr (Epi::MID) { if (k == Epi::MIDK) E.mid(acc, row0, r32, hi); }
            const bf16x8 fa0 = *(const bf16x8*)(a0 + k), fa1 = *(const bf16x8*)(a1 + k), fb0 = *(const bf16x8*)(b0 + k), fb1 = *(const bf16x8*)(b1 + k);
            acc[0][0] = __builtin_amdgcn_mfma_f32_32x32x16_bf16(fa0, fb0, acc[0][0], 0, 0, 0);
            acc[0][1] = __builtin_amdgcn_mfma_f32_32x32x16_bf16(fa0, fb1, acc[0][1], 0, 0, 0);
            acc[1][0] = __builtin_amdgcn_mfma_f32_32x32x16_bf16(fa1, fb0, acc[1][0], 0, 0, 0);
            acc[1][1] = __builtin_amdgcn_mfma_f32_32x32x16_bf16(fa1, fb1, acc[1][1], 0, 0, 0);
        }
        E.naive(acc, row0, col0, CS, r32, hi);
    }
}

__device__ __forceinline__ void rope_pair(float x1, float x2, int pi  , int t, float& o1, float& o2) {
    const int pos = pi < 16 ? (t >> 6) : (t & 63); const int fi = pi & 15;
    const float freq = exp2f(-(float)fi * (13.287712379549449f / 16.f));
    const float ang = (float)pos * freq; float rev = ang * 0.15915494309189535f; rev -= rintf(rev);
    const float s = __builtin_amdgcn_sinf(rev), c = __builtin_amdgcn_cosf(rev);
    o1 = x1 * c - x2 * s; o2 = x1 * s + x2 * c;
}
__device__ __forceinline__ void p2_qkconvert(const Params& p, int bid, int nb) {
    const int tid = threadIdx.x, lane = tid & 63, wave = tid >> 6; const int gw = bid * NWAVES + wave, NGW = nb * NWAVES;
    const float* AQKV = (const float*)(p.ws + WS_AQKV); bf16_t* QA = (bf16_t*)(p.ws + WS_QA); bf16_t* KA = (bf16_t*)(p.ws + WS_KA); bf16_t* VA = (bf16_t*)(p.ws + WS_VA); bf16_t* VT = (bf16_t*)(p.ws + WS_VT);
    const int pi = lane & 31;
    const f32x2 qw = *((const f32x2*)p.q_norm_w + pi), kw = *((const f32x2*)p.k_norm_w + pi);
    for (int m = gw; m < M; m += NGW) {
        const int t = m & (SEQ - 1), b = m >> 13; const float* row = AQKV + (size_t)m * 768;
#pragma unroll
        for (int j = 0; j < 4; ++j) {
            const f32x2 v = *((const f32x2*)row + 64 * j + lane); float ss = v.x * v.x + v.y * v.y;
#pragma unroll
            for (int o = 1; o < 32; o <<= 1) ss += __shfl_xor(ss, o);
            const float rstd = 1.f / sqrtf(ss * (1.f / 64.f) + EPS); float o1, o2; rope_pair(v.x * rstd * qw.x, v.y * rstd * qw.y, pi, t, o1, o2);
            *((unsigned*)(QA + (size_t)m * 512) + 64 * j + lane) = pk2(o1 * C2, o2 * C2);
        }
        {
            const f32x2 v = *((const f32x2*)(row + 512) + lane); float ss = v.x * v.x + v.y * v.y;
#pragma unroll
            for (int o = 1; o < 32; o <<= 1) ss += __shfl_xor(ss, o);
            const float rstd = 1.f / sqrtf(ss * (1.f / 64.f) + EPS); float o1, o2; rope_pair(v.x * rstd * kw.x, v.y * rstd * kw.y, pi, t, o1, o2);
            *((unsigned*)(KA + (size_t)m * 128) + lane) = pk2(o1, o2);
        }
        {
            const f32x2 v = *((const f32x2*)(row + 640) + lane); const unsigned w = pk2(v.x, v.y);
            *((unsigned*)(VA + (size_t)m * 128) + lane) = w;
            const int kvh = lane >> 5, d = 2 * (lane & 31);
            bf16_t* vt = VT + ((size_t)(b * 2 + kvh) * 64 + d) * SEQ + t; vt[0] = (bf16_t)(w & 0xffffu); vt[SEQ] = (bf16_t)(w >> 16);
        }
    }
}

__device__ __forceinline__ void nattn_unit(const bf16_t* QA, const bf16_t* KA, const bf16_t* VT, bf16_t* MIX, float* ssatt, int wu, int lane) {
    const int r32 = lane & 31, hi = lane >> 5; const int b = wu >> 11, hq = (wu >> 8) & 7, qb = wu & 255, kvh = hq >> 2;
    const size_t rowbase = (size_t)b * SEQ;
    const bf16_t* Qp = QA + (rowbase + qb * 32 + r32) * 512 + hq * 64 + hi * 8;
    bf16x8 qf[4];
#pragma unroll
    for (int d0 = 0; d0 < 4; ++d0) qf[d0] = *(const bf16x8*)(Qp + d0 * 16);
    const bf16_t* Kp = KA + (rowbase + r32) * 128 + kvh * 64 + hi * 8;
    const bf16_t* Vp = VT + ((size_t)(b * 2 + kvh) * 64 + r32) * SEQ + 4 * hi;
    f32x16 o0, o1;
#pragma unroll
    for (int r = 0; r < 16; ++r) { o0[r] = 0.f; o1[r] = 0.f; }
    float mrun = -1e30f, l = 0.f;
    for (int kv0 = 0; kv0 < SEQ; kv0 += 32) {
        f32x16 s;
#pragma unroll
        for (int r = 0; r < 16; ++r) s[r] = 0.f;
#pragma unroll
        for (int d0 = 0; d0 < 4; ++d0) { const bf16x8 kf = *(const bf16x8*)(Kp + (size_t)kv0 * 128 + d0 * 16); s = __builtin_amdgcn_mfma_f32_32x32x16_bf16(kf, qf[d0], s, 0, 0, 0); }
        float mx = s[0];
#pragma unroll
        for (int r = 1; r < 16; ++r) mx = fmaxf(mx, s[r]);
        mx = fmaxf(mx, __shfl_xor(mx, 32));
        const float mn = fmaxf(mrun, mx), alpha = __builtin_amdgcn_exp2f(mrun - mn); mrun = mn;
        float ps = 0.f;
#pragma unroll
        for (int r = 0; r < 16; ++r) { s[r] = __builtin_amdgcn_exp2f(s[r] - mn); ps += s[r]; }
        l = l * alpha + ps;
#pragma unroll
        for (int r = 0; r < 16; ++r) { o0[r] *= alpha; o1[r] *= alpha; }
#pragma unroll
        for (int si = 0; si < 2; ++si) {
            u32x4 pw; pw.x = pk2(s[8 * si + 0], s[8 * si + 1]); pw.y = pk2(s[8 * si + 2], s[8 * si + 3]); pw.z = pk2(s[8 * si + 4], s[8 * si + 5]); pw.w = pk2(s[8 * si + 6], s[8 * si + 7]);
            const bf16x8 pb = __builtin_bit_cast(bf16x8, pw);
            const bf16_t* vp = Vp + kv0 + 16 * si;
            { const bf16x4 lo = *(const bf16x4*)vp, h4 = *(const bf16x4*)(vp + 8); const bf16x8 vf = {lo[0], lo[1], lo[2], lo[3], h4[0], h4[1], h4[2], h4[3]}; o0 = __builtin_amdgcn_mfma_f32_32x32x16_bf16(vf, pb, o0, 0, 0, 0); }
            { const bf16_t* vq = vp + (size_t)32 * SEQ; const bf16x4 lo = *(const bf16x4*)vq, h4 = *(const bf16x4*)(vq + 8); const bf16x8 vf = {lo[0], lo[1], lo[2], lo[3], h4[0], h4[1], h4[2], h4[3]}; o1 = __builtin_amdgcn_mfma_f32_32x32x16_bf16(vf, pb, o1, 0, 0, 0); }
        }
    }
    l += __shfl_xor(l, 32); const float rl = 1.f / l; const size_t row = rowbase + qb * 32 + r32; float q = 0.f;
#pragma unroll
    for (int r = 0; r < 16; ++r) { const float a = o0[r] * rl, c = o1[r] * rl; q += a * a + c * c;
        MIX[row * 1024 + hq * 64 + crow(r, hi)] = (bf16_t)f2bf(a); MIX[row * 1024 + hq * 64 + 32 + crow(r, hi)] = (bf16_t)f2bf(c); }
    q += __shfl_xor(q, 32);
    if (hi == 0) atomicAdd(ssatt + row, q);
}

__device__ __forceinline__ void nhgrn_unit(const Params& p, LAS unsigned char* lds, int bh) {
    const int b = bh >> 2, h = bh & 3, tid = threadIdx.x, v = tid >> 2, kq = tid & 3;
    LAS float* Fs = (LAS float*)lds; LAS float* Qs = Fs + 8192; LAS float* Vs = Qs + 8192; LAS float* OL = Vs + 8192;
    const float* ZF = (const float*)(p.ws + WS_ZF); const bf16_t* QH = (const bf16_t*)(p.ws + WS_QH); const bf16_t* IV = (const bf16_t*)(p.ws + WS_IV); const bf16_t* GH = (const bf16_t*)(p.ws + WS_GH);
    float* OF = (float*)(p.ws + WS_XN); bf16_t* MIX = (bf16_t*)(p.ws + WS_MIX);
    for (int dir = 0; dir < 2; ++dir) {
        float S[32];
#pragma unroll
        for (int i = 0; i < 32; ++i) S[i] = 0.f;
        for (int cc = 0; cc < SEQ / 64; ++cc) {
            const int c = dir ? SEQ / 64 - 1 - cc : cc; const size_t r0 = (size_t)b * SEQ + c * 64;
#pragma unroll 4
            for (int i = 0; i < 16; ++i) { const int e = tid + 512 * i, tt = e >> 7, k = e & 127; const size_t row = r0 + tt;
                Fs[e] = ZF[row * 1024 + dir * 512 + h * 128 + k]; Qs[e] = bf2f(QH[row * 512 + h * 128 + k]); Vs[e] = bf2f(IV[row * 512 + h * 128 + k]); }
            __syncthreads();
            for (int s = 0; s < 64; ++s) { const int tt = dir ? 63 - s : s; const float vt = Vs[tt * 128 + v]; float o = 0.f;
#pragma unroll
                for (int kk = 0; kk < 32; kk += 4) { const f32x4 f = *(const LAS f32x4*)&Fs[tt * 128 + kq * 32 + kk], q = *(const LAS f32x4*)&Qs[tt * 128 + kq * 32 + kk];
                    S[kk + 0] = f.x * S[kk + 0] + (1.f - f.x) * vt; o += S[kk + 0] * q.x; S[kk + 1] = f.y * S[kk + 1] + (1.f - f.y) * vt; o += S[kk + 1] * q.y;
                    S[kk + 2] = f.z * S[kk + 2] + (1.f - f.z) * vt; o += S[kk + 2] * q.z; S[kk + 3] = f.w * S[kk + 3] + (1.f - f.w) * vt; o += S[kk + 3] * q.w; }
                o += __shfl_xor(o, 1); o += __shfl_xor(o, 2);
                if (kq == 0) OL[tt * 128 + v] = o; }
            __syncthreads();
            if (dir == 0) {
#pragma unroll 4
                for (int i = 0; i < 16; ++i) { const int e = tid + 512 * i, tt = e >> 7, k = e & 127; OF[(r0 + tt) * 512 + h * 128 + k] = OL[e]; }
            } else { const int tt = tid >> 3, sg = tid & 7; const size_t row = r0 + tt; float tot[16]; float ss = 0.f;
#pragma unroll
                for (int j = 0; j < 16; ++j) { const int vv = sg * 16 + j; tot[j] = OL[tt * 128 + vv] + OF[row * 512 + h * 128 + vv]; ss += tot[j] * tot[j]; }
                ss += __shfl_xor(ss, 1); ss += __shfl_xor(ss, 2); ss += __shfl_xor(ss, 4);
                const float rstd = 1.f / sqrtf(ss * (1.f / 128.f) + EPS);
#pragma unroll
                for (int j = 0; j < 16; ++j) { const int vv = sg * 16 + j; MIX[row * 1024 + 512 + h * 128 + vv] = (bf16_t)f2bf(tot[j] * rstd * p.hg_norm_w[vv] * bf2f(GH[row * 512 + h * 128 + vv])); }
            }
            __syncthreads();
        }
    }
}

__global__ void __launch_bounds__(NTHREADS, 2) fwd_kernel(Params p) {
    extern __shared__ __attribute__((aligned(16))) unsigned char lds_raw[];
    LAS unsigned char* lds = (LAS unsigned char*)lds_raw;
    cg::grid_group grid = cg::this_grid();
    const int bid = blockIdx.x, nb = gridDim.x, tid = threadIdx.x, lane = tid & 63, wave = tid >> 6;
    const int lo = p.ph_lo, hi = p.ph_hi;
#define IN(k) (lo <= (k) && (k) < hi)
#define SEAM(k) do { if (IN(k) && IN((k) + 1)) grid.sync(); } while (0)
    unsigned char* ws = p.ws;
    float* ssatt = (float*)(ws + WS_CTL + CTL_SSATT); float* ss2 = (float*)(ws + WS_CTL + CTL_SS2); float* ss3 = (float*)(ws + WS_CTL + CTL_SS3); const float* LB = (const float*)(ws + WS_CTL + CTL_LB);

    if (IN(0)) { p0_prologue(p, lds, bid, nb); } SEAM(0);
    if (IN(1)) { pg8::PgEpiIn E{(bf16_t*)(ws + WS_QH), (float*)(ws + WS_ZF), (bf16_t*)(ws + WS_IV), (bf16_t*)(ws + WS_GH), (float*)(ws + WS_AQKV), LB};
        pg8::Gemm g{(const bf16_t*)(ws + WS_XN), (const bf16_t*)(ws + WS_WIN), M, DIN, D}; pg8::StaticOrder S; S.init(M, DIN, nb, bid);
        pg8::gemm_phase<pg8::PgEpiIn, pg8::StaticOrder, true, true>(lds, g, S, E); } SEAM(1);
    if (IN(2)) { p2_qkconvert(p, bid, nb); } SEAM(2);
    if (IN(3)) {
        if (bid < 8 && nb > 8) nhgrn_unit(p, lds, bid);
        else { const int ab = nb > 8 ? bid - 8 : bid, anb = nb > 8 ? nb - 8 : nb;
            if (nb <= 8) { for (int u = bid; u < 8; u += nb) nhgrn_unit(p, lds, u); }
            for (int wu = ab * NWAVES + wave; wu < 4096; wu += anb * NWAVES)
                nattn_unit((const bf16_t*)(ws + WS_QA), (const bf16_t*)(ws + WS_KA), (const bf16_t*)(ws + WS_VT), (bf16_t*)(ws + WS_MIX), ssatt, wu, lane); }
    } SEAM(3);
    if (IN(4)) { pg8::PgEpiOut E{p.x, p.out, (bf16_t*)(ws + WS_XB), ss2, ssatt};
        pg8::Gemm g{(const bf16_t*)(ws + WS_MIX), (const bf16_t*)(ws + WS_WOUT), M, D, D}; pg8::StaticOrder S; S.init(M, D, nb, bid);
        pg8::gemm_phase<pg8::PgEpiOut, pg8::StaticOrder, true, true>(lds, g, S, E); } SEAM(4);
    if (IN(5)) { pg8::PgEpiGU E{(bf16_t*)(ws + WS_H), ss2};
        pg8::Gemm g{(const bf16_t*)(ws + WS_XB), (const bf16_t*)(ws + WS_WGU), M, 2 * DFF, D}; pg8::StaticOrder S; S.init(M, 2 * DFF, nb, bid);
        pg8::gemm_phase<pg8::PgEpiGU, pg8::StaticOrder, true, true>(lds, g, S, E); } SEAM(5);
    if (IN(6)) { pg8::PgEpiDown E{p.out, ss3};
        pg8::Gemm g{(const bf16_t*)(ws + WS_H), (const bf16_t*)(ws + WS_WDN), M, D, DFF}; pg8::StaticOrder S; S.init(M, D, nb, bid);
        pg8::gemm_phase<pg8::PgEpiDown, pg8::StaticOrder, true, true>(lds, g, S, E); } SEAM(6);
    if (IN(7)) {
        const int gw = bid * NWAVES + wave, NGW = nb * NWAVES;
        for (int m = gw; m < M; m += NGW) { f32x4* xr = (f32x4*)(p.out + (size_t)m * D) + lane; const f32x4* wr = (const f32x4*)p.final_norm_w + lane;
            const float rstd = 1.f / sqrtf(ss3[m] * (1.f / D) + EPS);
#pragma unroll
            for (int j = 0; j < 4; ++j) { f32x4 v = xr[64 * j]; const f32x4 w = wr[64 * j]; v.x *= rstd * w.x; v.y *= rstd * w.y; v.z *= rstd * w.z; v.w *= rstd * w.w; xr[64 * j] = v; } }
    }
#undef IN
#undef SEAM
}

extern "C" void kernel_launch(void* const* d_in, const int* in_sizes, int n_in, void* d_out, int out_size, void* d_ws, size_t ws_size, hipStream_t stream) {
    static int grid = 0;
    if (grid == 0) {
        if (n_in != 13 || in_sizes[0] != M * D || out_size != M * D || ws_size < WS_END) { fprintf(stderr, "kernel_launch: unexpected shapes (n_in %d, in0 %d, out %d, ws %zu)\n", n_in, n_in > 0 ? in_sizes[0] : -1, out_size, ws_size); grid = -1; return; }
        int dev = 0, cus = 0, per_cu = 0;
        hipGetDevice(&dev); hipDeviceGetAttribute(&cus, hipDeviceAttributeMultiprocessorCount, dev);
        if (hipFuncSetAttribute((const void*)fwd_kernel, hipFuncAttributeMaxDynamicSharedMemorySize, LDS_BYTES) != hipSuccess) { fprintf(stderr, "kernel_launch: hipFuncSetAttribute failed\n"); grid = -1; return; }
        if (hipOccupancyMaxActiveBlocksPerMultiprocessor(&per_cu, (const void*)fwd_kernel, NTHREADS, LDS_BYTES) != hipSuccess || per_cu < 1) { fprintf(stderr, "kernel_launch: occupancy query says %d\n", per_cu); per_cu = 1; }
        (void)hipGetLastError();
        grid = cus;
    }
    if (grid < 0) return;
    hipMemsetAsync((char*)d_ws + WS_CTL, 0, CTL_ZERO_BYTES, stream);
    Params p{};
    p.x = (const float*)d_in[0]; p.norm1_w = (const float*)d_in[1]; p.w_in = (const float*)d_in[2]; p.lb_logits = (const float*)d_in[3]; p.hg_norm_w = (const float*)d_in[4];
    p.q_norm_w = (const float*)d_in[5]; p.k_norm_w = (const float*)d_in[6]; p.att_norm_w = (const float*)d_in[7]; p.w_out = (const float*)d_in[8]; p.norm2_w = (const float*)d_in[9];
    p.w_gate_up = (const float*)d_in[10]; p.w_down = (const float*)d_in[11]; p.final_norm_w = (const float*)d_in[12];
    p.out = (float*)d_out; p.ws = (unsigned char*)d_ws;
#if MK_N_LAUNCHES == 1
    p.ph_lo = 0; p.ph_hi = NPH;
    void* args[] = {&p};
    hipError_t e = hipLaunchCooperativeKernel((const void*)fwd_kernel, dim3(grid), dim3(NTHREADS), args, LDS_BYTES, stream);
    if (e != hipSuccess) fprintf(stderr, "cooperative launch failed: %s (grid %d)\n", hipGetErrorString(e), grid);
#else
    for (int ph = 0; ph < NPH; ++ph) { p.ph_lo = ph; p.ph_hi = ph + 1; hipLaunchKernelGGL(fwd_kernel, dim3(grid), dim3(NTHREADS), LDS_BYTES, stream, p); }
#endif
}
```

```cpp
#include <hip/hip_runtime.h>
#include <hip/hip_cooperative_groups.h>
#include <cstdio>
#include <cstdint>
namespace cg = cooperative_groups;

#ifndef MK_N_LAUNCHES
#define MK_N_LAUNCHES 1
#endif

#define LAS __attribute__((address_space(3)))
typedef unsigned short bf16_t;
typedef short bf16x8 __attribute__((ext_vector_type(8)));
typedef short bf16x4 __attribute__((ext_vector_type(4)));
typedef float f32x2 __attribute__((ext_vector_type(2)));
typedef float f32x4 __attribute__((ext_vector_type(4)));
typedef float f32x16 __attribute__((ext_vector_type(16)));
typedef unsigned u32x2 __attribute__((ext_vector_type(2)));
typedef unsigned u32x4 __attribute__((ext_vector_type(4)));

constexpr int BATCH = 2, SEQ = 8192, M = BATCH * SEQ, D = 1024, DIN = 3328, DFF = 2816;
constexpr float EPS = 1e-6f;
constexpr float C2 = 0.125f * 1.4426950408889634f;
constexpr int NPH = 9;
constexpr int NTHREADS = 512, NWAVES = 8;
constexpr int LDS_BYTES = 147456;

constexpr size_t MiB = 1u << 20;
constexpr size_t WS_CTL = 0, CTL_ZERO_BYTES = 1 * MiB;
constexpr size_t CTL_SSATT = 64 * 1024, CTL_SS2 = 128 * 1024, CTL_SS3 = 192 * 1024, CTL_LB = 256 * 1024;
constexpr size_t WS_WIN = 1 * MiB, WS_WOUT = 8 * MiB, WS_WGU = 10 * MiB, WS_WDN = 21 * MiB;
constexpr size_t WS_XN = 27 * MiB;
constexpr size_t WS_QH = 59 * MiB;
constexpr size_t WS_IV = 75 * MiB;
constexpr size_t WS_GH = 91 * MiB;
constexpr size_t WS_ZF = 107 * MiB;
constexpr size_t WS_AQKV = 171 * MiB;
constexpr size_t WS_MIX = 171 * MiB;
constexpr size_t WS_QA = 219 * MiB;
constexpr size_t WS_KA = 235 * MiB;
constexpr size_t WS_VA = 239 * MiB;
constexpr size_t WS_VT = 243 * MiB;
constexpr size_t WS_SEND = 27 * MiB;
constexpr size_t WS_DTOT = 247 * MiB;
constexpr size_t WS_OFW = 203 * MiB;
constexpr size_t WS_XB = 59 * MiB;
constexpr size_t WS_H = 91 * MiB;
constexpr size_t WS_END = 256 * MiB;
static_assert(WS_WDN + (size_t)D * DFF * 2 <= WS_XN && WS_H + (size_t)M * DFF * 2 <= WS_QA && WS_VT + (size_t)4 * 64 * SEQ * 2 <= WS_END, "ws map");

struct Params {
    const float* x; const float* norm1_w; const float* w_in; const float* lb_logits; const float* hg_norm_w; const float* q_norm_w; const float* k_norm_w;
    const float* att_norm_w; const float* w_out; const float* norm2_w; const float* w_gate_up; const float* w_down; const float* final_norm_w;
    float* out; unsigned char* ws; int ph_lo, ph_hi;
};

__device__ __forceinline__ unsigned f2bf(float f) { unsigned u = __builtin_bit_cast(unsigned, f); return (u + 0x7fffu + ((u >> 16) & 1u)) >> 16; }
__device__ __forceinline__ unsigned pk2(float lo, float hi) { return f2bf(lo) | (f2bf(hi) << 16); }
__device__ __forceinline__ float bf2f(bf16_t b) { return __builtin_bit_cast(float, (unsigned)b << 16); }
__device__ __forceinline__ float silu_f(float v) { return v * __builtin_amdgcn_rcpf(1.f + __builtin_amdgcn_exp2f(-1.4426950408889634f * v)); }
__device__ __forceinline__ float sigmoid_f(float v) { return __builtin_amdgcn_rcpf(1.f + __builtin_amdgcn_exp2f(-1.4426950408889634f * v)); }
__device__ __forceinline__ int crow(int r, int hi) { return (r & 3) + 8 * (r >> 2) + 4 * hi; }
__device__ __forceinline__ float wave_sum(float v) {
#pragma unroll
    for (int o = 1; o < 64; o <<= 1) v += __shfl_xor(v, o);
    return v;
}

namespace pg8 {
#define PG8_LAS __attribute__((address_space(3)))
typedef unsigned short bf16_t;
typedef short bf16x8 __attribute__((ext_vector_type(8)));
typedef float f32x4 __attribute__((ext_vector_type(4)));
typedef unsigned u32x4 __attribute__((ext_vector_type(4)));
constexpr int BM = 256, BK = 64, HALF = 128, HTB = HALF * BK * 2  , STAGE_BYTES = 8 * HTB, NXCD = 8, WGM = 8;

__host__ __device__ __forceinline__ int lds_byte(int r, int c) { const int st = (r >> 4) * 2 + (c >> 5), rr = r & 15, cc = c & 31, ob = rr * 64 + cc * 2; return st * 1024 + (ob ^ (((ob >> 9) & 1) << 5)); }
__host__ __device__ __forceinline__ void stage_rc(int b, int& R, int& C) { const int st = b / 1024, sb = b % 1024, swz = sb ^ (((sb >> 9) & 1) << 5); R = (st >> 1) * 16 + swz / 64; C = (st & 1) * 32 + (swz % 64) / 2; }
__host__ __device__ __forceinline__ int perm32(int rho) { const int n = rho >> 4, i = rho & 15; return 8 * (i >> 2) + 4 * n + (i & 3); }

struct Unit { int pm, pn; };
struct Gemm { const bf16_t* A; const bf16_t* Bt; int M, N, K; };

struct StaticOrder {
    int nM, nN, nwg, G, c;
    __host__ __device__ void init(int M, int N, int G_, int c_) { nM = M / BM; nN = N / BM; nwg = nM * nN; G = G_; c = c_; }
    __host__ __device__ bool next(int i, Unit& u) const {
        const long L = (long)i * G + c; if (L >= nwg) return false;
        int wgid = (int)L; { const int q = nwg / NXCD, r = nwg % NXCD, xcd = wgid % NXCD, off = wgid / NXCD; wgid = (xcd < r ? xcd * (q + 1) : r * (q + 1) + (xcd - r) * q) + off; }
        const int nig = WGM * nN, gid = wgid / nig, fm = gid * WGM, gsz = (nM - fm) < WGM ? (nM - fm) : WGM;
        u.pm = fm + ((wgid % nig) % gsz); u.pn = (wgid % nig) / gsz; return true;
    }
    __device__ __forceinline__ void a_ready(const Unit&) const {}
    __device__ __forceinline__ void done(const Unit&) const {}
};

__device__ __forceinline__ unsigned cvt_pk_bf16(float lo, float hi) { unsigned r; asm volatile("v_cvt_pk_bf16_f32 %0, %1, %2" : "=v"(r) : "v"(lo), "v"(hi)); return r; }
typedef float f32x2 __attribute__((ext_vector_type(2)));
__device__ __forceinline__ f32x4 silu4(f32x4 v) { f32x4 o; o.x = silu_f(v.x); o.y = silu_f(v.y); o.z = silu_f(v.z); o.w = silu_f(v.w); return o; }
struct PgEpiIn {
    static constexpr bool PERM = true, AFTER_DRAIN = false, MID = false; static constexpr int MID_T = 0;
    bf16_t* QH; float* ZF; bf16_t* IV; bf16_t* GH; float* AQKV; const float* LB;
    __device__ __forceinline__ void mid(f32x4 (&)[2][2][4][2], const Unit&, int, int) const {}
    __device__ __forceinline__ void operator()(const f32x4 (&acc)[2][2][4][2], const Unit& u, int wr, int wc, int fr, int fq) const {
        const int row0 = u.pm * BM + wr * 64 + fr, pn = u.pn, cw = wc * 32 + 8 * fq;
        if (pn < 2 || (pn >= 6 && pn < 10)) {
            bf16_t* base; int colt; bool act;
            if (pn < 2) { base = QH; colt = pn * 256; act = true; } else if (pn < 8) { base = IV; colt = (pn - 6) * 256; act = false; } else { base = GH; colt = (pn - 8) * 256; act = true; }
#pragma unroll
            for (int ai = 0; ai < 2; ++ai)
#pragma unroll
                for (int m = 0; m < 4; ++m) { bf16_t* rowp = base + (size_t)(row0 + ai * HALF + m * 16) * 512 + colt + cw;
#pragma unroll
                    for (int bj = 0; bj < 2; ++bj) { f32x4 v0 = acc[ai][bj][m][0], v1 = acc[ai][bj][m][1]; if (act) { v0 = silu4(v0); v1 = silu4(v1); }
                        u32x4 w; w.x = cvt_pk_bf16(v0[0], v0[1]); w.y = cvt_pk_bf16(v0[2], v0[3]); w.z = cvt_pk_bf16(v1[0], v1[1]); w.w = cvt_pk_bf16(v1[2], v1[3]);
                        *(u32x4*)(rowp + bj * HALF) = w; } }
        } else if (pn < 6) {
            const int colt = (pn - 2) * 256; f32x4 lb[2][2];
#pragma unroll
            for (int bj = 0; bj < 2; ++bj)
#pragma unroll
                for (int n = 0; n < 2; ++n) lb[bj][n] = *(const f32x4*)(LB + colt + bj * HALF + cw + 4 * n);
#pragma unroll
            for (int ai = 0; ai < 2; ++ai)
#pragma unroll
                for (int m = 0; m < 4; ++m) { float* rowp = ZF + (size_t)(row0 + ai * HALF + m * 16) * 1024 + colt + cw;
#pragma unroll
                    for (int bj = 0; bj < 2; ++bj)
#pragma unroll
                        for (int n = 0; n < 2; ++n) { const f32x4 v = acc[ai][bj][m][n], l = lb[bj][n]; f32x4 f;
                            f.x = l.x + (1.f - l.x) * sigmoid_f(v.x); f.y = l.y + (1.f - l.y) * sigmoid_f(v.y); f.z = l.z + (1.f - l.z) * sigmoid_f(v.z); f.w = l.w + (1.f - l.w) * sigmoid_f(v.w);
                            *(f32x4*)(rowp + bj * HALF + 4 * n) = f; } }
        } else {
            const int colt = (pn - 10) * 256;
#pragma unroll
            for (int ai = 0; ai < 2; ++ai)
#pragma unroll
                for (int m = 0; m < 4; ++m) { float* rowp = AQKV + (size_t)(row0 + ai * HALF + m * 16) * 768 + colt + cw;
#pragma unroll
                    for (int bj = 0; bj < 2; ++bj)
#pragma unroll
                        for (int n = 0; n < 2; ++n) *(f32x4*)(rowp + bj * HALF + 4 * n) = acc[ai][bj][m][n]; }
        }
    }
};
struct PgEpiOut {
    static constexpr bool PERM = true, AFTER_DRAIN = false, MID = true; static constexpr int MID_T = 8;
    const float* x; float* out; bf16_t* XB; float* ss2; const float* ssatt;
    __device__ __forceinline__ void mid(f32x4 (&acc)[2][2][4][2], const Unit& u, int wr, int fr) const {
#pragma unroll
        for (int ai = 0; ai < 2; ++ai)
#pragma unroll
            for (int m = 0; m < 4; ++m) { const float s = 1.f / sqrtf(ssatt[u.pm * BM + ai * HALF + wr * 64 + m * 16 + fr] * (1.f / 512.f) + EPS);
#pragma unroll
                for (int bj = 0; bj < 2; ++bj)
#pragma unroll
                    for (int n = 0; n < 2; ++n) acc[ai][bj][m][n] *= s; }
    }
    __device__ __forceinline__ void operator()(const f32x4 (&acc)[2][2][4][2], const Unit& u, int wr, int wc, int fr, int fq) const {
#pragma unroll
        for (int ai = 0; ai < 2; ++ai)
#pragma unroll
            for (int m = 0; m < 4; ++m) { const int row = u.pm * BM + ai * HALF + wr * 64 + m * 16 + fr; float q = 0.f;
#pragma unroll
                for (int bj = 0; bj < 2; ++bj) { const size_t idx = (size_t)row * D + u.pn * BM + bj * HALF + wc * 32 + 8 * fq;
                    const f32x4 v0 = *(const f32x4*)(x + idx) + acc[ai][bj][m][0], v1 = *(const f32x4*)(x + idx + 4) + acc[ai][bj][m][1];
                    *(f32x4*)(out + idx) = v0; *(f32x4*)(out + idx + 4) = v1;
                    u32x4 w; w.x = cvt_pk_bf16(v0[0], v0[1]); w.y = cvt_pk_bf16(v0[2], v0[3]); w.z = cvt_pk_bf16(v1[0], v1[1]); w.w = cvt_pk_bf16(v1[2], v1[3]);
                    *(u32x4*)(XB + idx) = w;
                    q += (v0[0] * v0[0] + v0[1] * v0[1]) + (v0[2] * v0[2] + v0[3] * v0[3]) + (v1[0] * v1[0] + v1[1] * v1[1]) + (v1[2] * v1[2] + v1[3] * v1[3]); }
                q += __shfl_xor(q, 16); q += __shfl_xor(q, 32);
                if (fq == 0) atomicAdd(ss2 + row, q); }
    }
};
struct PgEpiGU {
    static constexpr bool PERM = true, AFTER_DRAIN = false, MID = false; static constexpr int MID_T = 0;
    bf16_t* H; const float* ss2;
    __device__ __forceinline__ void mid(f32x4 (&)[2][2][4][2], const Unit&, int, int) const {}
    __device__ __forceinline__ void operator()(const f32x4 (&acc)[2][2][4][2], const Unit& u, int wr, int wc, int fr, int fq) const {
#pragma unroll
        for (int ai = 0; ai < 2; ++ai)
#pragma unroll
            for (int m = 0; m < 4; ++m) { const int row = u.pm * BM + ai * HALF + wr * 64 + m * 16 + fr; const float s = 1.f / sqrtf(ss2[row] * (1.f / D) + EPS);
                const f32x4 a0 = silu4(acc[ai][0][m][0] * s) * (acc[ai][1][m][0] * s), a1 = silu4(acc[ai][0][m][1] * s) * (acc[ai][1][m][1] * s);
                u32x4 w; w.x = cvt_pk_bf16(a0[0], a0[1]); w.y = cvt_pk_bf16(a0[2], a0[3]); w.z = cvt_pk_bf16(a1[0], a1[1]); w.w = cvt_pk_bf16(a1[2], a1[3]);
                *(u32x4*)(H + (size_t)row * DFF + 128 * u.pn + wc * 32 + 8 * fq) = w; }
    }
};
struct PgEpiDown {
    static constexpr bool PERM = true, AFTER_DRAIN = false, MID = false; static constexpr int MID_T = 0;
    float* out; float* ss3;
    __device__ __forceinline__ void mid(f32x4 (&)[2][2][4][2], const Unit&, int, int) const {}
    __device__ __forceinline__ void operator()(const f32x4 (&acc)[2][2][4][2], const Unit& u, int wr, int wc, int fr, int fq) const {
#pragma unroll
        for (int ai = 0; ai < 2; ++ai)
#pragma unroll
            for (int m = 0; m < 4; ++m) { const int row = u.pm * BM + ai * HALF + wr * 64 + m * 16 + fr; float q = 0.f;
#pragma unroll
                for (int bj = 0; bj < 2; ++bj) { const size_t idx = (size_t)row * D + u.pn * BM + bj * HALF + wc * 32 + 8 * fq;
                    const f32x4 v0 = *(const f32x4*)(out + idx) + acc[ai][bj][m][0], v1 = *(const f32x4*)(out + idx + 4) + acc[ai][bj][m][1];
                    *(f32x4*)(out + idx) = v0; *(f32x4*)(out + idx + 4) = v1;
                    q += (v0[0] * v0[0] + v0[1] * v0[1]) + (v0[2] * v0[2] + v0[3] * v0[3]) + (v1[0] * v1[0] + v1[1] * v1[1]) + (v1[2] * v1[2] + v1[3] * v1[3]); }
                q += __shfl_xor(q, 16); q += __shfl_xor(q, 32);
                if (fq == 0) atomicAdd(ss3 + row, q); }
    }
};
template <class Epi, class Sched, bool ALIGN_EPI = false, bool SP2 = false>
__device__ __forceinline__ void gemm_phase(PG8_LAS unsigned char* lds, const Gemm g, const Sched& S, const Epi& E) {
    const int tid = threadIdx.x, wid = __builtin_amdgcn_readfirstlane(tid >> 6), lane = tid & 63, wr = wid >> 2, wc = wid & 3, fr = lane & 15, fq = lane >> 4;
    const int K = g.K, nt = K / BK;
    unsigned voffA[2], voffB[2];
#pragma unroll
    for (int i = 0; i < 2; ++i) { int R, C; stage_rc(tid * 16 + i * 8192, R, C); const int Rb = Epi::PERM ? ((R & ~31) + perm32(R & 31)) : R;
        voffA[i] = (unsigned)(R * K + C) * 2u; voffB[i] = (unsigned)(Rb * K + C) * 2u; }
    const size_t kstep = (size_t)(BK * 2);
    const size_t hstep = (size_t)HALF * K * 2;
    const size_t tstep = 2 * hstep;
    const unsigned ldsw = (unsigned)wid * 1024u;
    const int aoff = lds_byte(wr * 64 + fr, fq * 8), boff = lds_byte(wc * 32 + fr, fq * 8);
#define PG8_SA(b, h) (((b) * 2 + (h)) * HTB)
#define PG8_SB(b, h) ((4 + (b) * 2 + (h)) * HTB)
#define PG8_STAGE(bufoff, gbase, voff) do { _Pragma("unroll") for (int _i = 0; _i < 2; ++_i) \
        __builtin_amdgcn_global_load_lds((const unsigned*)((const char*)(gbase) + (voff)[_i]), (PG8_LAS unsigned*)(lds + (bufoff) + ldsw + _i * 8192), 16, 0, 0); } while (0)
#define PG8_LDA(dst, b, h) do { _Pragma("unroll") for (int m = 0; m < 4; ++m) _Pragma("unroll") for (int k = 0; k < 2; ++k) dst[m][k] = *(const PG8_LAS bf16x8*)(lds + PG8_SA(b, h) + aoff + m * 2048 + k * 1024); } while (0)
#define PG8_LDB(dst, b, h) do { _Pragma("unroll") for (int n = 0; n < 2; ++n) _Pragma("unroll") for (int k = 0; k < 2; ++k) dst[n][k] = *(const PG8_LAS bf16x8*)(lds + PG8_SB(b, h) + boff + n * 2048 + k * 1024); } while (0)
#define PG8_MMA(ai, bj, At, Bt) do { __builtin_amdgcn_s_setprio(1); _Pragma("unroll") for (int m = 0; m < 4; ++m) _Pragma("unroll") for (int n = 0; n < 2; ++n) _Pragma("unroll") for (int k = 0; k < 2; ++k) \
        acc[ai][bj][m][n] = __builtin_amdgcn_mfma_f32_16x16x32_bf16(Bt[n][k], At[m][k], acc[ai][bj][m][n], 0, 0, 0); __builtin_amdgcn_s_setprio(0); } while (0)
#define PG8_WAIT_V(n) asm volatile("s_waitcnt vmcnt(" #n ")" ::: "memory")
#define PG8_WAIT_L(n) asm volatile("s_waitcnt lgkmcnt(" #n ")" ::: "memory")
#define PG8_BAR __builtin_amdgcn_s_barrier()
#define PG8_SCHED __builtin_amdgcn_sched_barrier(0)
    Unit cur, nxt; int ui = 0;
    if (!S.next(0, cur)) return;
    f32x4 acc[2][2][4][2];
#pragma unroll
    for (int a = 0; a < 2; ++a)
#pragma unroll
        for (int b = 0; b < 2; ++b)
#pragma unroll
            for (int m = 0; m < 4; ++m)
#pragma unroll
                for (int n = 0; n < 2; ++n) acc[a][b][m][n] = (f32x4){0.f, 0.f, 0.f, 0.f};
    bf16x8 At[4][2], B0[2][2], B1[2][2];
    const char* cA = (const char*)g.A + (size_t)cur.pm * tstep; const char* cB = (const char*)g.Bt + (size_t)cur.pn * tstep;
    S.a_ready(cur);
    if constexpr (SP2) {
        PG8_STAGE(PG8_SB(0, 0), cB, voffB); PG8_STAGE(PG8_SB(0, 1), cB + hstep, voffB); PG8_STAGE(PG8_SA(0, 0), cA, voffA); PG8_STAGE(PG8_SA(0, 1), cA + hstep, voffA);
        if (wr == 1) PG8_BAR;
        PG8_WAIT_V(2); PG8_BAR;
        PG8_STAGE(PG8_SB(1, 0), cB + kstep, voffB); PG8_STAGE(PG8_SA(1, 0), cA + kstep, voffA); PG8_STAGE(PG8_SB(1, 1), cB + hstep + kstep, voffB);
        PG8_WAIT_V(6); PG8_BAR;
    } else {
        PG8_STAGE(PG8_SB(0, 0), cB, voffB); PG8_STAGE(PG8_SA(0, 0), cA, voffA); PG8_STAGE(PG8_SB(0, 1), cB + hstep, voffB); PG8_STAGE(PG8_SA(0, 1), cA + hstep, voffA);
        if (wr == 1) PG8_BAR;
        PG8_WAIT_V(4); PG8_BAR;
        PG8_STAGE(PG8_SB(1, 0), cB + kstep, voffB); PG8_STAGE(PG8_SA(1, 0), cA + kstep, voffA); PG8_STAGE(PG8_SB(1, 1), cB + hstep + kstep, voffB);
        PG8_WAIT_V(6); PG8_BAR;
    }
    for (;;) {
        const bool has_next = S.next(ui + 1, nxt);
        const char* nA = has_next ? (const char*)g.A + (size_t)nxt.pm * tstep : cA; const char* nB = has_next ? (const char*)g.Bt + (size_t)nxt.pn * tstep : cB;
        for (int t = 0; t < nt; t += 2) {
            const bool last = (t == nt - 2);
            if constexpr (Epi::MID) { if (t == Epi::MID_T) E.mid(acc, cur, wr, fr); }
            const char* a1 = cA + (size_t)(t + 1) * kstep;
            const char* a2 = last ? nA : cA + (size_t)(t + 2) * kstep; const char* b2 = last ? nB : cB + (size_t)(t + 2) * kstep;
            const char* a3 = a2 + kstep; const char* b3 = b2 + kstep;
            if (last && has_next) S.a_ready(nxt);
            if constexpr (SP2) {
            PG8_LDB(B0, 0, 0); PG8_LDB(B1, 0, 1); PG8_SCHED; PG8_LDA(At, 0, 0); PG8_STAGE(PG8_SA(1, 1), a1 + hstep, voffA);
            PG8_WAIT_V(8); PG8_WAIT_L(0); PG8_BAR; PG8_MMA(0, 0, At, B0); PG8_MMA(0, 1, At, B1); PG8_BAR; PG8_SCHED;
            PG8_LDA(At, 0, 1); PG8_STAGE(PG8_SB(0, 0), b2, voffB); PG8_STAGE(PG8_SB(0, 1), b2 + hstep, voffB); PG8_STAGE(PG8_SA(0, 0), a2, voffA);
            PG8_WAIT_V(8); PG8_WAIT_L(0); PG8_BAR; PG8_MMA(1, 0, At, B0); PG8_MMA(1, 1, At, B1); PG8_BAR; PG8_SCHED;
            PG8_LDB(B0, 1, 0); PG8_LDB(B1, 1, 1); PG8_SCHED; PG8_LDA(At, 1, 0); PG8_STAGE(PG8_SA(0, 1), a2 + hstep, voffA);
            PG8_WAIT_V(8); PG8_WAIT_L(0); PG8_BAR; PG8_MMA(0, 0, At, B0); PG8_MMA(0, 1, At, B1); PG8_BAR; PG8_SCHED;
            PG8_LDA(At, 1, 1); PG8_STAGE(PG8_SB(1, 0), b3, voffB); PG8_STAGE(PG8_SB(1, 1), b3 + hstep, voffB); PG8_STAGE(PG8_SA(1, 0), a3, voffA);
            PG8_WAIT_V(8); PG8_WAIT_L(0); PG8_BAR; PG8_MMA(1, 0, At, B0); PG8_MMA(1, 1, At, B1); PG8_BAR; PG8_SCHED;
            } else {
            PG8_LDB(B0, 0, 0); PG8_SCHED; PG8_LDA(At, 0, 0); PG8_STAGE(PG8_SA(1, 1), a1 + hstep, voffA);
            PG8_WAIT_L(8); PG8_BAR; PG8_WAIT_L(0); PG8_MMA(0, 0, At, B0); PG8_BAR; PG8_SCHED;
            PG8_LDB(B1, 0, 1); PG8_STAGE(PG8_SB(0, 0), b2, voffB);
            PG8_BAR; PG8_WAIT_L(0); PG8_MMA(0, 1, At, B1); PG8_BAR;
            PG8_LDA(At, 0, 1); PG8_STAGE(PG8_SA(0, 0), a2, voffA);
            PG8_BAR; PG8_WAIT_L(0); PG8_MMA(1, 0, At, B0); PG8_BAR; PG8_SCHED;
            PG8_STAGE(PG8_SB(0, 1), b2 + hstep, voffB);
            PG8_WAIT_V(6); PG8_BAR; PG8_MMA(1, 1, At, B1); PG8_BAR;
            PG8_LDB(B0, 1, 0); PG8_SCHED; PG8_LDA(At, 1, 0); PG8_STAGE(PG8_SA(0, 1), a2 + hstep, voffA);
            PG8_WAIT_L(8); PG8_BAR; PG8_WAIT_L(0); PG8_MMA(0, 0, At, B0); PG8_BAR; PG8_SCHED;
            PG8_LDB(B1, 1, 1); PG8_STAGE(PG8_SB(1, 0), b3, voffB);
            PG8_BAR; PG8_WAIT_L(0); PG8_MMA(0, 1, At, B1); PG8_BAR;
            PG8_LDA(At, 1, 1); PG8_STAGE(PG8_SA(1, 0), a3, voffA);
            PG8_BAR; PG8_WAIT_L(0); PG8_MMA(1, 0, At, B0); PG8_BAR; PG8_SCHED;
            PG8_STAGE(PG8_SB(1, 1), b3 + hstep, voffB);
            PG8_WAIT_V(6); PG8_BAR; PG8_MMA(1, 1, At, B1); PG8_BAR;
            }
        }
        if constexpr (ALIGN_EPI) { if (wr == 0) PG8_BAR; }
        if constexpr (!Epi::AFTER_DRAIN) { E(acc, cur, wr, wc, fr, fq); S.done(cur); }
        if (!has_next) break;
#pragma unroll
        for (int a = 0; a < 2; ++a)
#pragma unroll
            for (int b = 0; b < 2; ++b)
#pragma unroll
                for (int m = 0; m < 4; ++m)
#pragma unroll
                    for (int n = 0; n < 2; ++n) acc[a][b][m][n] = (f32x4){0.f, 0.f, 0.f, 0.f};
        cur = nxt; cA = nA; cB = nB; ++ui;
        if constexpr (ALIGN_EPI) { if (wr == 1) PG8_BAR; }
    }
    PG8_WAIT_V(0);
    if constexpr (!ALIGN_EPI) { if (wr == 0) PG8_BAR; }
    PG8_BAR;
    if constexpr (Epi::AFTER_DRAIN) { E.fused(acc, cur, wr, wc, fr, fq, lds, wid, lane); S.done(cur); }
#undef PG8_SA
#undef PG8_SB
#undef PG8_STAGE
#undef PG8_LDA
#undef PG8_LDB
#undef PG8_MMA
#undef PG8_WAIT_V
#undef PG8_WAIT_L
#undef PG8_BAR
#undef PG8_SCHED
}
}

__device__ __forceinline__ void transpose_item(const float* W, int N, bf16_t* WT, int Kd, int k_src0, int k_dst0, int n_src0, int n_dst0, const float* sc, LAS float* scr, int lane) {
#pragma unroll 8
    for (int i = 0; i < 32; ++i) { const int kk = 2 * i + (lane >> 5); float v = W[(size_t)(k_src0 + kk) * N + n_src0 + (lane & 31)]; if (sc) v *= sc[k_src0 + kk]; scr[kk * 33 + (lane & 31)] = v; }
    asm volatile("s_waitcnt lgkmcnt(0)" ::: "memory");
    const int c = lane & 7;
#pragma unroll
    for (int j = 0; j < 4; ++j) { const int n = (lane >> 3) + 8 * j; const LAS float* s = scr + (8 * c) * 33 + n;
        u32x4 o; o.x = pk2(s[0 * 33], s[1 * 33]); o.y = pk2(s[2 * 33], s[3 * 33]); o.z = pk2(s[4 * 33], s[5 * 33]); o.w = pk2(s[6 * 33], s[7 * 33]);
        *(u32x4*)(WT + (size_t)(n_dst0 + n) * Kd + k_dst0 + 8 * c) = o; }
    asm volatile("s_waitcnt lgkmcnt(0)" ::: "memory");
}

__device__ __forceinline__ void p0_prologue(const Params& p, LAS unsigned char* lds, int bid, int nb) {
    const int tid = threadIdx.x, lane = tid & 63, wave = tid >> 6;
    LAS float* scr = (LAS float*)(lds + wave * 16384);
    const int gw = bid * NWAVES + wave, NGW = nb * NWAVES;
    bf16_t* Win_t = (bf16_t*)(p.ws + WS_WIN); bf16_t* Wout_t = (bf16_t*)(p.ws + WS_WOUT); bf16_t* Wgu_t = (bf16_t*)(p.ws + WS_WGU); bf16_t* Wdn_t = (bf16_t*)(p.ws + WS_WDN);
    constexpr int I_IN = (D / 64) * (DIN / 32), I_OUT = (D / 64) * (D / 32), I_GU = (D / 64) * (2 * DFF / 32), I_DN = (DFF / 64) * (D / 32);
    constexpr int NITEMS = I_IN + I_OUT + I_GU + I_DN;
    for (int it = gw; it < NITEMS; it += NGW) {
        int r = it;
        if (r < I_IN) { const int nblk = DIN / 32, kb = r / nblk, nbk = r % nblk; transpose_item(p.w_in, DIN, Win_t, D, 64 * kb, 64 * kb, 32 * nbk, 32 * nbk, nullptr, scr, lane); continue; } r -= I_IN;
        if (r < I_OUT) { const int nblk = D / 32, kb = r / nblk, nbk = r % nblk; const int ks = 64 * kb;
            transpose_item(p.w_out, D, Wout_t, D, ks, (ks + 512) & 1023, 32 * nbk, 32 * nbk, ks >= 512 ? p.att_norm_w - 512 : nullptr, scr, lane); continue; } r -= I_OUT;
        if (r < I_GU) { const int nblk = 2 * DFF / 32, kb = r / nblk, nbk = r % nblk; const int nd = 32 * nbk, pn = nd >> 8, nn = nd & 255;
            const int ns = nn < 128 ? 128 * pn + nn : DFF + 128 * pn + nn - 128;
            transpose_item(p.w_gate_up, 2 * DFF, Wgu_t, D, 64 * kb, 64 * kb, ns, nd, p.norm2_w, scr, lane); continue; } r -= I_GU;
        { const int nblk = D / 32, kb = r / nblk, nbk = r % nblk; transpose_item(p.w_down, D, Wdn_t, DFF, 64 * kb, 64 * kb, 32 * nbk, 32 * nbk, nullptr, scr, lane); }
    }
    bf16_t* XN = (bf16_t*)(p.ws + WS_XN);
    for (int m = gw; m < M; m += NGW) {
        const f32x4* xr = (const f32x4*)(p.x + (size_t)m * D) + lane; const f32x4* wr = (const f32x4*)p.norm1_w + lane;
        f32x4 v[4]; float s = 0.f;
#pragma unroll
        for (int j = 0; j < 4; ++j) { v[j] = xr[64 * j]; s += (v[j].x * v[j].x + v[j].y * v[j].y) + (v[j].z * v[j].z + v[j].w * v[j].w); }
        const float rstd = 1.f / sqrtf(wave_sum(s) * (1.f / D) + EPS);
        unsigned long long* o8 = (unsigned long long*)(XN + (size_t)m * D) + lane;
#pragma unroll
        for (int j = 0; j < 4; ++j) { const f32x4 w = wr[64 * j]; o8[64 * j] = (unsigned long long)pk2(v[j].x * rstd * w.x, v[j].y * rstd * w.y) | ((unsigned long long)pk2(v[j].z * rstd * w.z, v[j].w * rstd * w.w) << 32); }
    }
    if (bid == 0) { float* LB = (float*)(p.ws + WS_CTL + CTL_LB);
        for (int j = tid; j < 1024; j += NTHREADS) { const int d = j >> 9, jj = j & 511; const float a0 = p.lb_logits[d * 1024 + jj], a1 = p.lb_logits[d * 1024 + 512 + jj]; LB[j] = 1.f / (1.f + expf(a1 - a0)); } }
}

struct EpiIn {
    static constexpr bool PAIR = false, MID = false;
    bf16_t* QH; float* ZF; bf16_t* IV; bf16_t* GH; float* AQKV; const float* LB;
    __device__ __forceinline__ void elem(int row, int col, float v) const {
        if (col < 512) QH[(size_t)row * 512 + col] = (bf16_t)f2bf(silu_f(v));
        else if (col < 1536) { const int c = col - 512; const float lb = LB[c]; ZF[(size_t)row * 1024 + c] = lb + (1.f - lb) * sigmoid_f(v); }
        else if (col < 2048) IV[(size_t)row * 512 + col - 1536] = (bf16_t)f2bf(v);
        else if (col < 2560) GH[(size_t)row * 512 + col - 2048] = (bf16_t)f2bf(silu_f(v));
        else AQKV[(size_t)row * 768 + col - 2560] = v;
    }
    __device__ __forceinline__ void naive(f32x16 (&acc)[2][2], int row0, int col0, int cs, int r32, int hi) const {
#pragma unroll
        for (int i = 0; i < 2; ++i)
#pragma unroll
            for (int j = 0; j < 2; ++j)
#pragma unroll
                for (int r = 0; r < 16; ++r) elem(row0 + 32 * i + crow(r, hi), col0 + j * cs + r32, acc[i][j][r]);
    }
    __device__ __forceinline__ void mid(f32x16 (&)[2][2], int, int, int) const {}
};
struct EpiOut {
    static constexpr bool PAIR = false, MID = true; static constexpr int MIDK = 512;
    const float* x; float* out; bf16_t* XB; float* ss2; const float* ssatt;
    __device__ __forceinline__ void mid(f32x16 (&acc)[2][2], int row0, int r32, int hi) const {
#pragma unroll
        for (int i = 0; i < 2; ++i)
#pragma unroll
            for (int r = 0; r < 16; ++r) { const float s = 1.f / sqrtf(ssatt[row0 + 32 * i + crow(r, hi)] * (1.f / 512.f) + EPS); acc[i][0][r] *= s; acc[i][1][r] *= s; }
    }
    __device__ __forceinline__ void naive(f32x16 (&acc)[2][2], int row0, int col0, int cs, int r32, int hi) const {
#pragma unroll
        for (int i = 0; i < 2; ++i)
#pragma unroll
            for (int r = 0; r < 16; ++r) { const int row = row0 + 32 * i + crow(r, hi); float q = 0.f;
#pragma unroll
                for (int j = 0; j < 2; ++j) { const size_t idx = (size_t)row * D + col0 + j * cs + r32; const float v = x[idx] + acc[i][j][r]; out[idx] = v; XB[idx] = (bf16_t)f2bf(v); q += v * v; }
#pragma unroll
                for (int o = 1; o < 32; o <<= 1) q += __shfl_xor(q, o);
                if (r32 == 0) atomicAdd(ss2 + row, q); }
    }
};
struct EpiGU {
    static constexpr bool PAIR = true, MID = false;
    bf16_t* H; const float* ss2;
    __device__ __forceinline__ void naive(f32x16 (&acc)[2][2], int row0, int col0, int cs, int r32, int hi) const {
        const int pn = col0 >> 8, cc = (col0 & 255) + r32;
#pragma unroll
        for (int i = 0; i < 2; ++i)
#pragma unroll
            for (int r = 0; r < 16; ++r) { const int row = row0 + 32 * i + crow(r, hi); const float s = 1.f / sqrtf(ss2[row] * (1.f / D) + EPS);
                H[(size_t)row * DFF + 128 * pn + cc] = (bf16_t)f2bf(silu_f(acc[i][0][r] * s) * (acc[i][1][r] * s)); }
    }
    __device__ __forceinline__ void mid(f32x16 (&)[2][2], int, int, int) const {}
};
struct EpiDown {
    static constexpr bool PAIR = false, MID = false;
    float* out; float* ss3;
    __device__ __forceinline__ void naive(f32x16 (&acc)[2][2], int row0, int col0, int cs, int r32, int hi) const {
#pragma unroll
        for (int i = 0; i < 2; ++i)
#pragma unroll
            for (int r = 0; r < 16; ++r) { const int row = row0 + 32 * i + crow(r, hi); float q = 0.f;
#pragma unroll
                for (int j = 0; j < 2; ++j) { const size_t idx = (size_t)row * D + col0 + j * cs + r32; const float v = out[idx] + acc[i][j][r]; out[idx] = v; q += v * v; }
#pragma unroll
                for (int o = 1; o < 32; o <<= 1) q += __shfl_xor(q, o);
                if (r32 == 0) atomicAdd(ss3 + row, q); }
    }
    __device__ __forceinline__ void mid(f32x16 (&)[2][2], int, int, int) const {}
};

template <class Epi>
__device__ __forceinline__ void ngemm_phase(const bf16_t* A, const bf16_t* Bt, int M_, int N_, int K_, const Epi& E, int bid, int nb) {
    const int tid = threadIdx.x, lane = tid & 63, wid = tid >> 6, r32 = lane & 31, hi = lane >> 5, wr = wid >> 2, wc = wid & 3;
    const int nM = M_ / 128, nN = N_ / 256; constexpr int CS = Epi::PAIR ? 128 : 32;
    for (int u = bid; u < nM * nN; u += nb) {
        const int pm = u / nN, pn = u % nN;
        const int row0 = pm * 128 + wr * 64, col0 = pn * 256 + (Epi::PAIR ? wc * 32 : wc * 64);
        f32x16 acc[2][2];
#pragma unroll
        for (int i = 0; i < 2; ++i)
#pragma unroll
            for (int j = 0; j < 2; ++j)
#pragma unroll
                for (int r = 0; r < 16; ++r) acc[i][j][r] = 0.f;
        const bf16_t* a0 = A + (size_t)(row0 + r32) * K_ + hi * 8; const bf16_t* a1 = a0 + (size_t)32 * K_;
        const bf16_t* b0 = Bt + (size_t)(col0 + r32) * K_ + hi * 8; const bf16_t* b1 = b0 + (size_t)CS * K_;
        for (int k = 0; k < K_; k += 16) {
            if constexpr (Epi::MID) { if (k == Epi::MIDK) E.mid(acc, row0, r32, hi); }
            const bf16x8 fa0 = *(const bf16x8*)(a0 + k), fa1 = *(const bf16x8*)(a1 + k), fb0 = *(const bf16x8*)(b0 + k), fb1 = *(const bf16x8*)(b1 + k);
            acc[0][0] = __builtin_amdgcn_mfma_f32_32x32x16_bf16(fa0, fb0, acc[0][0], 0, 0, 0);
            acc[0][1] = __builtin_amdgcn_mfma_f32_32x32x16_bf16(fa0, fb1, acc[0][1], 0, 0, 0);
            acc[1][0] = __builtin_amdgcn_mfma_f32_32x32x16_bf16(fa1, fb0, acc[1][0], 0, 0, 0);
            acc[1][1] = __builtin_amdgcn_mfma_f32_32x32x16_bf16(fa1, fb1, acc[1][1], 0, 0, 0);
        }
        E.naive(acc, row0, col0, CS, r32, hi);
    }
}

__device__ __forceinline__ void rope_pair(float x1, float x2, int pi  , int t, float& o1, float& o2) {
    const int pos = pi < 16 ? (t >> 6) : (t & 63); const int fi = pi & 15;
    const float freq = exp2f(-(float)fi * (13.287712379549449f / 16.f));
    const float ang = (float)pos * freq; float rev = ang * 0.15915494309189535f; rev -= rintf(rev);
    const float s = __builtin_amdgcn_sinf(rev), c = __builtin_amdgcn_cosf(rev);
    o1 = x1 * c - x2 * s; o2 = x1 * s + x2 * c;
}
__device__ __forceinline__ void p2_qkconvert(const Params& p, int bid, int nb) {
    const int tid = threadIdx.x, lane = tid & 63, wave = tid >> 6; const int gw = bid * NWAVES + wave, NGW = nb * NWAVES;
    const float* AQKV = (const float*)(p.ws + WS_AQKV); bf16_t* QA = (bf16_t*)(p.ws + WS_QA); bf16_t* KA = (bf16_t*)(p.ws + WS_KA); bf16_t* VA = (bf16_t*)(p.ws + WS_VA); bf16_t* VT = (bf16_t*)(p.ws + WS_VT);
    const int pi = lane & 31;
    const f32x2 qw = *((const f32x2*)p.q_norm_w + pi), kw = *((const f32x2*)p.k_norm_w + pi);
    for (int m = gw; m < M; m += NGW) {
        const int t = m & (SEQ - 1), b = m >> 13; const float* row = AQKV + (size_t)m * 768;
#pragma unroll
        for (int j = 0; j < 4; ++j) {
            const f32x2 v = *((const f32x2*)row + 64 * j + lane); float ss = v.x * v.x + v.y * v.y;
#pragma unroll
            for (int o = 1; o < 32; o <<= 1) ss += __shfl_xor(ss, o);
            const float rstd = 1.f / sqrtf(ss * (1.f / 64.f) + EPS); float o1, o2; rope_pair(v.x * rstd * qw.x, v.y * rstd * qw.y, pi, t, o1, o2);
            *((unsigned*)(QA + (size_t)m * 512) + 64 * j + lane) = pk2(o1 * C2, o2 * C2);
        }
        {
            const f32x2 v = *((const f32x2*)(row + 512) + lane); float ss = v.x * v.x + v.y * v.y;
#pragma unroll
            for (int o = 1; o < 32; o <<= 1) ss += __shfl_xor(ss, o);
            const float rstd = 1.f / sqrtf(ss * (1.f / 64.f) + EPS); float o1, o2; rope_pair(v.x * rstd * kw.x, v.y * rstd * kw.y, pi, t, o1, o2);
            *((unsigned*)(KA + (size_t)m * 128) + lane) = pk2(o1, o2);
        }
        {
            const f32x2 v = *((const f32x2*)(row + 640) + lane); const unsigned w = pk2(v.x, v.y);
            *((unsigned*)(VA + (size_t)m * 128) + lane) = w;
            const int kvh = lane >> 5, d = 2 * (lane & 31);
            bf16_t* vt = VT + ((size_t)(b * 2 + kvh) * 64 + d) * SEQ + t; vt[0] = (bf16_t)(w & 0xffffu); vt[SEQ] = (bf16_t)(w >> 16);
        }
    }
}

__device__ __forceinline__ void nattn_unit(const bf16_t* QA, const bf16_t* KA, const bf16_t* VT, bf16_t* MIX, float* ssatt, int wu, int lane) {
    const int r32 = lane & 31, hi = lane >> 5; const int b = wu >> 11, hq = (wu >> 8) & 7, qb = wu & 255, kvh = hq >> 2;
    const size_t rowbase = (size_t)b * SEQ;
    const bf16_t* Qp = QA + (rowbase + qb * 32 + r32) * 512 + hq * 64 + hi * 8;
    bf16x8 qf[4];
#pragma unroll
    for (int d0 = 0; d0 < 4; ++d0) qf[d0] = *(const bf16x8*)(Qp + d0 * 16);
    const bf16_t* Kp = KA + (rowbase + r32) * 128 + kvh * 64 + hi * 8;
    const bf16_t* Vp = VT + ((size_t)(b * 2 + kvh) * 64 + r32) * SEQ + 4 * hi;
    f32x16 o0, o1;
#pragma unroll
    for (int r = 0; r < 16; ++r) { o0[r] = 0.f; o1[r] = 0.f; }
    float mrun = -1e30f, l = 0.f;
    for (int kv0 = 0; kv0 < SEQ; kv0 += 32) {
        f32x16 s;
#pragma unroll
        for (int r = 0; r < 16; ++r) s[r] = 0.f;
#pragma unroll
        for (int d0 = 0; d0 < 4; ++d0) { const bf16x8 kf = *(const bf16x8*)(Kp + (size_t)kv0 * 128 + d0 * 16); s = __builtin_amdgcn_mfma_f32_32x32x16_bf16(kf, qf[d0], s, 0, 0, 0); }
        float mx = s[0];
#pragma unroll
        for (int r = 1; r < 16; ++r) mx = fmaxf(mx, s[r]);
        mx = fmaxf(mx, __shfl_xor(mx, 32));
        const float mn = fmaxf(mrun, mx), alpha = __builtin_amdgcn_exp2f(mrun - mn); mrun = mn;
        float ps = 0.f;
#pragma unroll
        for (int r = 0; r < 16; ++r) { s[r] = __builtin_amdgcn_exp2f(s[r] - mn); ps += s[r]; }
        l = l * alpha + ps;
#pragma unroll
        for (int r = 0; r < 16; ++r) { o0[r] *= alpha; o1[r] *= alpha; }
#pragma unroll
        for (int si = 0; si < 2; ++si) {
            u32x4 pw; pw.x = pk2(s[8 * si + 0], s[8 * si + 1]); pw.y = pk2(s[8 * si + 2], s[8 * si + 3]); pw.z = pk2(s[8 * si + 4], s[8 * si + 5]); pw.w = pk2(s[8 * si + 6], s[8 * si + 7]);
            const bf16x8 pb = __builtin_bit_cast(bf16x8, pw);
            const bf16_t* vp = Vp + kv0 + 16 * si;
            { const bf16x4 lo = *(const bf16x4*)vp, h4 = *(const bf16x4*)(vp + 8); const bf16x8 vf = {lo[0], lo[1], lo[2], lo[3], h4[0], h4[1], h4[2], h4[3]}; o0 = __builtin_amdgcn_mfma_f32_32x32x16_bf16(vf, pb, o0, 0, 0, 0); }
            { const bf16_t* vq = vp + (size_t)32 * SEQ; const bf16x4 lo = *(const bf16x4*)vq, h4 = *(const bf16x4*)(vq + 8); const bf16x8 vf = {lo[0], lo[1], lo[2], lo[3], h4[0], h4[1], h4[2], h4[3]}; o1 = __builtin_amdgcn_mfma_f32_32x32x16_bf16(vf, pb, o1, 0, 0, 0); }
        }
    }
    l += __shfl_xor(l, 32); const float rl = 1.f / l; const size_t row = rowbase + qb * 32 + r32; float q = 0.f;
#pragma unroll
    for (int r = 0; r < 16; ++r) { const float a = o0[r] * rl, c = o1[r] * rl; q += a * a + c * c;
        MIX[row * 1024 + hq * 64 + crow(r, hi)] = (bf16_t)f2bf(a); MIX[row * 1024 + hq * 64 + 32 + crow(r, hi)] = (bf16_t)f2bf(c); }
    q += __shfl_xor(q, 32);
    if (hi == 0) atomicAdd(ssatt + row, q);
}

namespace hg {
constexpr int RS = 136, RS2 = 72, OLS = 132;
constexpr int QB_OFF = 0, QI_OFF = 17408, KI_OFF = 34816, KCT_OFF = 52224, VT_OFF = 70656, SPT_OFF = 89088, PP_OFF = 123904, SEGT_OFF = 133120, DEC_OFF = 135168, HG_LDS = 135680;
static_assert(HG_LDS <= LDS_BYTES && 64 * OLS * 4 <= KI_OFF, "hgrn lds map");
constexpr int NSC = 32;
#define HG_BAR() do { asm volatile("s_waitcnt vmcnt(0) lgkmcnt(0)" ::: "memory"); __builtin_amdgcn_s_barrier(); asm volatile("" ::: "memory"); } while (0)
#define HG_LD8(off, row, rs, col) (*(const LAS bf16x8*)(lds + (off) + ((row) * (rs) + (col)) * 2))

template <int DIR, bool OUT>
__device__ __forceinline__ void chunk_step(const Params& p, LAS unsigned char* lds, int b, int h, int chunk, f32x16 (&S)[2], f32x16& o, float& tsum) {
    const int tid = threadIdx.x, lane = tid & 63, wid = tid >> 6, r32 = lane & 31, hi = lane >> 5, c = tid & 127, seg = tid >> 7;
    const size_t r0 = (size_t)b * SEQ + chunk * 64 + seg * 16;
    const float* zf = (const float*)(p.ws + WS_ZF) + r0 * 1024 + DIR * 512 + h * 128 + c;
    const bf16_t* qh = (const bf16_t*)(p.ws + WS_QH) + r0 * 512 + h * 128 + c;
    const bf16_t* iv = (const bf16_t*)(p.ws + WS_IV) + r0 * 512 + h * 128 + c;
    LAS float* SEGT = (LAS float*)(lds + SEGT_OFF); LAS float* DEC = (LAS float*)(lds + DEC_OFF);
    float lf[16], kk[16], qv[16]; unsigned vraw[16];
#pragma unroll
    for (int j = 0; j < 16; ++j) { lf[j] = zf[(size_t)j * 1024]; vraw[j] = iv[(size_t)j * 512]; if (OUT) qv[j] = bf2f(qh[(size_t)j * 512]); }
#pragma unroll
    for (int j = 0; j < 16; ++j) { kk[j] = 1.f - lf[j]; lf[j] = __logf(lf[j]); }
    if (DIR == 0) {
#pragma unroll
        for (int j = 1; j < 16; ++j) lf[j] += lf[j - 1];
        SEGT[seg * 128 + c] = lf[15];
    } else {
#pragma unroll
        for (int j = 14; j >= 0; --j) lf[j] += lf[j + 1];
        SEGT[seg * 128 + c] = lf[0];
    }
    HG_BAR();
    const float t0 = SEGT[c], t1 = SEGT[128 + c], t2 = SEGT[256 + c], t3 = SEGT[384 + c];
    const float total = (t0 + t1) + (t2 + t3);
    const float off = DIR == 0 ? (seg == 0 ? 0.f : seg == 1 ? t0 : seg == 2 ? t0 + t1 : t0 + t1 + t2) : (seg == 3 ? 0.f : seg == 2 ? t3 : seg == 1 ? t2 + t3 : t1 + t2 + t3);
    const float bref = DIR == 0 ? t0 + t1 : t2 + t3;
    unsigned kcw[8], vw[8];
#pragma unroll
    for (int j = 0; j < 16; j += 2) {
        const float b0 = lf[j] + off, b1 = lf[j + 1] + off;
        kcw[j >> 1] = pk2(kk[j] * __expf(total - b0), kk[j + 1] * __expf(total - b1));
        vw[j >> 1] = vraw[j] | (vraw[j + 1] << 16);
        if (OUT) {
            const int row0 = (seg * 16 + j) * RS + c, row1 = row0 + RS;
            ((LAS bf16_t*)(lds + QB_OFF))[row0] = (bf16_t)f2bf(qv[j] * __expf(b0)); ((LAS bf16_t*)(lds + QB_OFF))[row1] = (bf16_t)f2bf(qv[j + 1] * __expf(b1));
            ((LAS bf16_t*)(lds + QI_OFF))[row0] = (bf16_t)f2bf(qv[j] * __expf(b0 - bref)); ((LAS bf16_t*)(lds + QI_OFF))[row1] = (bf16_t)f2bf(qv[j + 1] * __expf(b1 - bref));
            ((LAS bf16_t*)(lds + KI_OFF))[row0] = (bf16_t)f2bf(kk[j] * __expf(bref - b0)); ((LAS bf16_t*)(lds + KI_OFF))[row1] = (bf16_t)f2bf(kk[j + 1] * __expf(bref - b1));
        }
    }
    { LAS u32x4* kd = (LAS u32x4*)(lds + KCT_OFF + (c * RS2 + seg * 16) * 2); kd[0] = (u32x4){kcw[0], kcw[1], kcw[2], kcw[3]}; kd[1] = (u32x4){kcw[4], kcw[5], kcw[6], kcw[7]};
      LAS u32x4* vd = (LAS u32x4*)(lds + VT_OFF + (c * RS2 + seg * 16) * 2); vd[0] = (u32x4){vw[0], vw[1], vw[2], vw[3]}; vd[1] = (u32x4){vw[4], vw[5], vw[6], vw[7]}; }
    if (seg == 0) DEC[c] = __expf(total);
    tsum += total;
    const int cb = 2 * (wid >> 2), vb = wid & 3;
    if (OUT) {
#pragma unroll
        for (int i = 0; i < 2; ++i)
#pragma unroll
            for (int g = 0; g < 4; ++g) { u32x2 w; w.x = pk2(S[i][4 * g], S[i][4 * g + 1]); w.y = pk2(S[i][4 * g + 2], S[i][4 * g + 3]);
                *(LAS u32x2*)(lds + SPT_OFF + ((32 * vb + r32) * RS + 32 * (cb + i) + 8 * g + 4 * hi) * 2) = w; }
    }
    HG_BAR();
    if (OUT) {
        if (wid < 4) { const int tb = wid >> 1, sb = wid & 1; const bool skip = DIR == 0 ? (tb == 0 && sb == 1) : (tb == 1 && sb == 0);
            f32x16 sc;
#pragma unroll
            for (int r = 0; r < 16; ++r) sc[r] = 0.f;
            if (!skip) {
#pragma unroll
                for (int k8 = 0; k8 < 8; ++k8) sc = __builtin_amdgcn_mfma_f32_32x32x16_bf16(HG_LD8(QI_OFF, 32 * tb + r32, RS, 16 * k8 + 8 * hi), HG_LD8(KI_OFF, 32 * sb + r32, RS, 16 * k8 + 8 * hi), sc, 0, 0, 0);
            }
#pragma unroll
            for (int r = 0; r < 16; ++r) { const int t = 32 * tb + crow(r, hi), s = 32 * sb + r32; const bool keep = DIR == 0 ? s <= t : s >= t;
                ((LAS bf16_t*)(lds + PP_OFF))[t * RS2 + s] = keep ? (bf16_t)f2bf(sc[r]) : (bf16_t)0; }
        }
        HG_BAR();
        { const int tb = wid >> 2;
#pragma unroll
            for (int r = 0; r < 16; ++r) o[r] = 0.f;
#pragma unroll
            for (int k8 = 0; k8 < 8; ++k8) o = __builtin_amdgcn_mfma_f32_32x32x16_bf16(HG_LD8(QB_OFF, 32 * tb + r32, RS, 16 * k8 + 8 * hi), HG_LD8(SPT_OFF, 32 * vb + r32, RS, 16 * k8 + 8 * hi), o, 0, 0, 0);
#pragma unroll
            for (int k4 = 0; k4 < 4; ++k4) o = __builtin_amdgcn_mfma_f32_32x32x16_bf16(HG_LD8(PP_OFF, 32 * tb + r32, RS2, 16 * k4 + 8 * hi), HG_LD8(VT_OFF, 32 * vb + r32, RS2, 16 * k4 + 8 * hi), o, 0, 0, 0);
        }
    }
#pragma unroll
    for (int i = 0; i < 2; ++i) { const int c0 = 32 * (cb + i);
#pragma unroll
        for (int r = 0; r < 16; ++r) S[i][r] *= DEC[c0 + crow(r, hi)];
#pragma unroll
        for (int k4 = 0; k4 < 4; ++k4) S[i] = __builtin_amdgcn_mfma_f32_32x32x16_bf16(HG_LD8(KCT_OFF, c0 + r32, RS2, 16 * k4 + 8 * hi), HG_LD8(VT_OFF, 32 * vb + r32, RS2, 16 * k4 + 8 * hi), S[i], 0, 0, 0);
    }
}

template <int DIR>
__device__ __forceinline__ void pass1_unit(const Params& p, LAS unsigned char* lds, int b, int h, int sc) {
    const int tid = threadIdx.x, lane = tid & 63, wid = tid >> 6;
    f32x16 S[2]; f32x16 odummy; float tsum = 0.f;
#pragma unroll
    for (int i = 0; i < 2; ++i)
#pragma unroll
        for (int r = 0; r < 16; ++r) S[i][r] = 0.f;
    for (int ci = 0; ci < 4; ++ci) chunk_step<DIR, false>(p, lds, b, h, sc * 4 + (DIR ? 3 - ci : ci), S, odummy, tsum);
    const size_t seq = (size_t)((DIR * 2 + b) * 4 + h) * NSC + sc;
    float* send = (float*)(p.ws + WS_SEND) + seq * 16384;
#pragma unroll
    for (int i = 0; i < 2; ++i)
#pragma unroll
        for (int r = 0; r < 16; ++r) send[((wid * 2 + i) * 16 + r) * 64 + lane] = S[i][r];
    if (tid < 128) ((float*)(p.ws + WS_DTOT))[seq * 128 + tid] = __expf(tsum);
    HG_BAR();
}

__device__ __forceinline__ void scan_phase(const Params& p, int bid, int nb) {
    float* SEND = (float*)(p.ws + WS_SEND); const float* DTOT = (const float*)(p.ws + WS_DTOT);
    for (int idx = bid * NTHREADS + threadIdx.x; idx < 16 * 16384; idx += nb * NTHREADS) {
        const int sq = idx >> 14, e = idx & 16383, dir = sq >> 3; const int ln = e & 63, reg = (e >> 6) & 15, i = (e >> 10) & 1, w = e >> 11;
        const int c = 32 * (2 * (w >> 2) + i) + crow(reg, ln >> 5);
        float* base = SEND + (size_t)sq * NSC * 16384 + e; const float* dt = DTOT + (size_t)sq * NSC * 128 + c;
        float run = 0.f;
        if (dir == 0) { for (int sc = 0; sc < NSC; ++sc) { const float end = base[(size_t)sc * 16384]; base[(size_t)sc * 16384] = run; run = dt[sc * 128] * run + end; } }
        else { for (int sc = NSC - 1; sc >= 0; --sc) { const float end = base[(size_t)sc * 16384]; base[(size_t)sc * 16384] = run; run = dt[sc * 128] * run + end; } }
    }
}

__device__ __forceinline__ void pass2_unit(const Params& p, LAS unsigned char* lds, int b, int h, int sc) {
    const int tid = threadIdx.x, lane = tid & 63, wid = tid >> 6, r32 = lane & 31, hi = lane >> 5;
    f32x16 S[2]; float tsum = 0.f;
    unsigned* ofw = (unsigned*)(p.ws + WS_OFW) + (size_t)blockIdx.x * 16384 + wid * 512 + lane;
    { const float* send = (const float*)(p.ws + WS_SEND) + ((size_t)((0 * 2 + b) * 4 + h) * NSC + sc) * 16384;
#pragma unroll
      for (int i = 0; i < 2; ++i)
#pragma unroll
          for (int r = 0; r < 16; ++r) S[i][r] = send[((wid * 2 + i) * 16 + r) * 64 + lane]; }
#pragma unroll 1
    for (int ci = 0; ci < 4; ++ci) { f32x16 o; chunk_step<0, true>(p, lds, b, h, sc * 4 + ci, S, o, tsum);
#pragma unroll
        for (int k = 0; k < 8; ++k) ofw[ci * 4096 + k * 64] = pk2(o[2 * k], o[2 * k + 1]); }
    { const float* send = (const float*)(p.ws + WS_SEND) + ((size_t)((1 * 2 + b) * 4 + h) * NSC + sc) * 16384;
#pragma unroll
      for (int i = 0; i < 2; ++i)
#pragma unroll
          for (int r = 0; r < 16; ++r) S[i][r] = send[((wid * 2 + i) * 16 + r) * 64 + lane]; }
    const bf16_t* GH = (const bf16_t*)(p.ws + WS_GH); bf16_t* MIX = (bf16_t*)(p.ws + WS_MIX);
#pragma unroll 1
    for (int cj = 0; cj < 4; ++cj) { const int ci = 3 - cj; f32x16 o;
        chunk_step<1, true>(p, lds, b, h, sc * 4 + ci, S, o, tsum);
#pragma unroll
        for (int k = 0; k < 8; ++k) { const unsigned w = ofw[ci * 4096 + k * 64]; o[2 * k] += __builtin_bit_cast(float, w << 16); o[2 * k + 1] += __builtin_bit_cast(float, w & 0xffff0000u); }
        HG_BAR();
        LAS float* OL = (LAS float*)lds; const int tb = wid >> 2, vb = wid & 3;
#pragma unroll
        for (int r = 0; r < 16; ++r) OL[(32 * tb + crow(r, hi)) * OLS + 32 * vb + r32] = o[r];
        HG_BAR();
        { const int tt = tid >> 3, sg = tid & 7; const size_t row = (size_t)b * SEQ + (sc * 4 + ci) * 64 + tt; float tot[16]; float ss = 0.f;
#pragma unroll
          for (int j = 0; j < 16; j += 4) { const f32x4 v = *(const LAS f32x4*)(OL + tt * OLS + sg * 16 + j); tot[j] = v.x; tot[j + 1] = v.y; tot[j + 2] = v.z; tot[j + 3] = v.w; ss += (v.x * v.x + v.y * v.y) + (v.z * v.z + v.w * v.w); }
          ss += __shfl_xor(ss, 1); ss += __shfl_xor(ss, 2); ss += __shfl_xor(ss, 4);
          const float rstd = 1.f / sqrtf(ss * (1.f / 128.f) + EPS);
          const u32x4 g0 = *(const u32x4*)(GH + row * 512 + h * 128 + sg * 16), g1 = *(const u32x4*)(GH + row * 512 + h * 128 + sg * 16 + 8);
          const unsigned gw[8] = {g0.x, g0.y, g0.z, g0.w, g1.x, g1.y, g1.z, g1.w}; unsigned ow[8];
#pragma unroll
          for (int j = 0; j < 16; j += 2) { const float w0 = p.hg_norm_w[sg * 16 + j], w1 = p.hg_norm_w[sg * 16 + j + 1]; const unsigned g = gw[j >> 1];
              ow[j >> 1] = pk2(tot[j] * rstd * w0 * __builtin_bit_cast(float, g << 16), tot[j + 1] * rstd * w1 * __builtin_bit_cast(float, g & 0xffff0000u)); }
          u32x4* dst = (u32x4*)(MIX + row * 1024 + 512 + h * 128 + sg * 16); dst[0] = (u32x4){ow[0], ow[1], ow[2], ow[3]}; dst[1] = (u32x4){ow[4], ow[5], ow[6], ow[7]}; }
    }
    HG_BAR();
}
#undef HG_BAR
#undef HG_LD8
}

__global__ void __launch_bounds__(NTHREADS, 2) fwd_kernel(Params p) {
    extern __shared__ __attribute__((aligned(16))) unsigned char lds_raw[];
    LAS unsigned char* lds = (LAS unsigned char*)lds_raw;
    cg::grid_group grid = cg::this_grid();
    const int bid = blockIdx.x, nb = gridDim.x, tid = threadIdx.x, lane = tid & 63, wave = tid >> 6;
    const int lo = p.ph_lo, hi = p.ph_hi;
#define IN(k) (lo <= (k) && (k) < hi)
#define SEAM(k) do { if (IN(k) && IN((k) + 1)) grid.sync(); } while (0)
    unsigned char* ws = p.ws;
    float* ssatt = (float*)(ws + WS_CTL + CTL_SSATT); float* ss2 = (float*)(ws + WS_CTL + CTL_SS2); float* ss3 = (float*)(ws + WS_CTL + CTL_SS3); const float* LB = (const float*)(ws + WS_CTL + CTL_LB);

    if (IN(0)) { p0_prologue(p, lds, bid, nb); } SEAM(0);
    if (IN(1)) { pg8::PgEpiIn E{(bf16_t*)(ws + WS_QH), (float*)(ws + WS_ZF), (bf16_t*)(ws + WS_IV), (bf16_t*)(ws + WS_GH), (float*)(ws + WS_AQKV), LB};
        pg8::Gemm g{(const bf16_t*)(ws + WS_XN), (const bf16_t*)(ws + WS_WIN), M, DIN, D}; pg8::StaticOrder S; S.init(M, DIN, nb, bid);
        pg8::gemm_phase<pg8::PgEpiIn, pg8::StaticOrder, true, true>(lds, g, S, E); } SEAM(1);
    if (IN(2)) { p2_qkconvert(p, bid, nb);
        for (int u = bid; u < 512; u += nb) { const int dir = u >> 8, b = (u >> 7) & 1, h = (u >> 5) & 3, sc = u & 31; if (dir == 0) hg::pass1_unit<0>(p, lds, b, h, sc); else hg::pass1_unit<1>(p, lds, b, h, sc); }
    } SEAM(2);
    if (IN(3)) { hg::scan_phase(p, bid, nb); } SEAM(3);
    if (IN(4)) {
        for (int u = bid; u < 256; u += nb) hg::pass2_unit(p, lds, u >> 7, (u >> 5) & 3, u & 31);
        for (int wu = bid * NWAVES + wave; wu < 4096; wu += nb * NWAVES)
            nattn_unit((const bf16_t*)(ws + WS_QA), (const bf16_t*)(ws + WS_KA), (const bf16_t*)(ws + WS_VT), (bf16_t*)(ws + WS_MIX), ssatt, wu, lane);
    } SEAM(4);
    if (IN(5)) { pg8::PgEpiOut E{p.x, p.out, (bf16_t*)(ws + WS_XB), ss2, ssatt};
        pg8::Gemm g{(const bf16_t*)(ws + WS_MIX), (const bf16_t*)(ws + WS_WOUT), M, D, D}; pg8::StaticOrder S; S.init(M, D, nb, bid);
        pg8::gemm_phase<pg8::PgEpiOut, pg8::StaticOrder, true, true>(lds, g, S, E); } SEAM(5);
    if (IN(6)) { pg8::PgEpiGU E{(bf16_t*)(ws + WS_H), ss2};
        pg8::Gemm g{(const bf16_t*)(ws + WS_XB), (const bf16_t*)(ws + WS_WGU), M, 2 * DFF, D}; pg8::StaticOrder S; S.init(M, 2 * DFF, nb, bid);
        pg8::gemm_phase<pg8::PgEpiGU, pg8::StaticOrder, true, true>(lds, g, S, E); } SEAM(6);
    if (IN(7)) { pg8::PgEpiDown E{p.out, ss3};
        pg8::Gemm g{(const bf16_t*)(ws + WS_H), (const bf16_t*)(ws + WS_WDN), M, D, DFF}; pg8::StaticOrder S; S.init(M, D, nb, bid);
        pg8::gemm_phase<pg8::PgEpiDown, pg8::StaticOrder, true, true>(lds, g, S, E); } SEAM(7);
    if (IN(8)) {
        const int gw = bid * NWAVES + wave, NGW = nb * NWAVES;
        for (int m = gw; m < M; m += NGW) { f32x4* xr = (f32x4*)(p.out + (size_t)m * D) + lane; const f32x4* wr = (const f32x4*)p.final_norm_w + lane;
            const float rstd = 1.f / sqrtf(ss3[m] * (1.f / D) + EPS);
#pragma unroll
            for (int j = 0; j < 4; ++j) { f32x4 v = xr[64 * j]; const f32x4 w = wr[64 * j]; v.x *= rstd * w.x; v.y *= rstd * w.y; v.z *= rstd * w.z; v.w *= rstd * w.w; xr[64 * j] = v; } }
    }
#undef IN
#undef SEAM
}

extern "C" void kernel_launch(void* const* d_in, const int* in_sizes, int n_in, void* d_out, int out_size, void* d_ws, size_t ws_size, hipStream_t stream) {
    static int grid = 0;
    if (grid == 0) {
        if (n_in != 13 || in_sizes[0] != M * D || out_size != M * D || ws_size < WS_END) { fprintf(stderr, "kernel_launch: unexpected shapes (n_in %d, in0 %d, out %d, ws %zu)\n", n_in, n_in > 0 ? in_sizes[0] : -1, out_size, ws_size); grid = -1; return; }
        int dev = 0, cus = 0, per_cu = 0;
        hipGetDevice(&dev); hipDeviceGetAttribute(&cus, hipDeviceAttributeMultiprocessorCount, dev);
        if (hipFuncSetAttribute((const void*)fwd_kernel, hipFuncAttributeMaxDynamicSharedMemorySize, LDS_BYTES) != hipSuccess) { fprintf(stderr, "kernel_launch: hipFuncSetAttribute failed\n"); grid = -1; return; }
        if (hipOccupancyMaxActiveBlocksPerMultiprocessor(&per_cu, (const void*)fwd_kernel, NTHREADS, LDS_BYTES) != hipSuccess || per_cu < 1) { fprintf(stderr, "kernel_launch: occupancy query says %d\n", per_cu); per_cu = 1; }
        (void)hipGetLastError();
        grid = cus;
    }
    if (grid < 0) return;
    hipMemsetAsync((char*)d_ws + WS_CTL, 0, CTL_ZERO_BYTES, stream);
    Params p{};
    p.x = (const float*)d_in[0]; p.norm1_w = (const float*)d_in[1]; p.w_in = (const float*)d_in[2]; p.lb_logits = (const float*)d_in[3]; p.hg_norm_w = (const float*)d_in[4];
    p.q_norm_w = (const float*)d_in[5]; p.k_norm_w = (const float*)d_in[6]; p.att_norm_w = (const float*)d_in[7]; p.w_out = (const float*)d_in[8]; p.norm2_w = (const float*)d_in[9];
    p.w_gate_up = (const float*)d_in[10]; p.w_down = (const float*)d_in[11]; p.final_norm_w = (const float*)d_in[12];
    p.out = (float*)d_out; p.ws = (unsigned char*)d_ws;
#if MK_N_LAUNCHES == 1
    p.ph_lo = 0; p.ph_hi = NPH;
    void* args[] = {&p};
    hipError_t e = hipLaunchCooperativeKernel((const void*)fwd_kernel, dim3(grid), dim3(NTHREADS), args, LDS_BYTES, stream);
    if (e != hipSuccess) fprintf(stderr, "cooperative launch failed: %s (grid %d)\n", hipGetErrorString(e), grid);
#else
    for (int ph = 0; ph < NPH; ++ph) { p.ph_lo = ph; p.ph_hi = ph + 1; hipLaunchKernelGGL(fwd_kernel, dim3(grid), dim3(NTHREADS), LDS_BYTES, stream, p); }
#endif
}
```

```cpp
#include <hip/hip_runtime.h>
#include <hip/hip_cooperative_groups.h>
#include <cstdio>
#include <cstdint>
namespace cg = cooperative_groups;

#ifndef MK_N_LAUNCHES
#define MK_N_LAUNCHES 1
#endif

#define LAS __attribute__((address_space(3)))
typedef unsigned short bf16_t;
typedef short bf16x8 __attribute__((ext_vector_type(8)));
typedef short bf16x4 __attribute__((ext_vector_type(4)));
typedef float f32x2 __attribute__((ext_vector_type(2)));
typedef float f32x4 __attribute__((ext_vector_type(4)));
typedef float f32x16 __attribute__((ext_vector_type(16)));
typedef unsigned u32x2 __attribute__((ext_vector_type(2)));
typedef unsigned u32x4 __attribute__((ext_vector_type(4)));

constexpr int BATCH = 2, SEQ = 8192, M = BATCH * SEQ, D = 1024, DIN = 3328, DFF = 2816;
constexpr float EPS = 1e-6f;
constexpr float C2 = 0.125f * 1.4426950408889634f;
constexpr int NPH = 9;
constexpr int NTHREADS = 512, NWAVES = 8;
constexpr int LDS_BYTES = 147456;

constexpr size_t MiB = 1u << 20;
constexpr size_t WS_CTL = 0, CTL_ZERO_BYTES = 1 * MiB;
constexpr size_t CTL_SSATT = 64 * 1024, CTL_SS2 = 128 * 1024, CTL_SS3 = 192 * 1024, CTL_LB = 256 * 1024;
constexpr size_t WS_WIN = 1 * MiB, WS_WOUT = 8 * MiB, WS_WGU = 10 * MiB, WS_WDN = 21 * MiB;
constexpr size_t WS_XN = 27 * MiB;
constexpr size_t WS_QH = 59 * MiB;
constexpr size_t WS_IV = 75 * MiB;
constexpr size_t WS_GH = 91 * MiB;
constexpr size_t WS_ZF = 107 * MiB;
constexpr size_t WS_AQKV = 171 * MiB;
constexpr size_t WS_MIX = 171 * MiB;
constexpr size_t WS_QA = 219 * MiB;
constexpr size_t WS_KA = 235 * MiB;
constexpr size_t WS_VA = 239 * MiB;
constexpr size_t WS_VT = 243 * MiB;
constexpr size_t WS_SEND = 27 * MiB;
constexpr size_t WS_DTOT = 247 * MiB;
constexpr size_t WS_OFW = 203 * MiB;
constexpr size_t WS_XB = 59 * MiB;
constexpr size_t WS_H = 91 * MiB;
constexpr size_t WS_END = 256 * MiB;
static_assert(WS_WDN + (size_t)D * DFF * 2 <= WS_XN && WS_H + (size_t)M * DFF * 2 <= WS_QA && WS_VT + (size_t)4 * 64 * SEQ * 2 <= WS_END, "ws map");

struct Params {
    const float* x; const float* norm1_w; const float* w_in; const float* lb_logits; const float* hg_norm_w; const float* q_norm_w; const float* k_norm_w;
    const float* att_norm_w; const float* w_out; const float* norm2_w; const float* w_gate_up; const float* w_down; const float* final_norm_w;
    float* out; unsigned char* ws; int ph_lo, ph_hi;
};

__device__ __forceinline__ unsigned f2bf(float f) { unsigned u = __builtin_bit_cast(unsigned, f); return (u + 0x7fffu + ((u >> 16) & 1u)) >> 16; }
__device__ __forceinline__ unsigned pk2(float lo, float hi) { return f2bf(lo) | (f2bf(hi) << 16); }
__device__ __forceinline__ float bf2f(bf16_t b) { return __builtin_bit_cast(float, (unsigned)b << 16); }
__device__ __forceinline__ float silu_f(float v) { return v * __builtin_amdgcn_rcpf(1.f + __builtin_amdgcn_exp2f(-1.4426950408889634f * v)); }
__device__ __forceinline__ float sigmoid_f(float v) { return __builtin_amdgcn_rcpf(1.f + __builtin_amdgcn_exp2f(-1.4426950408889634f * v)); }
__device__ __forceinline__ int crow(int r, int hi) { return (r & 3) + 8 * (r >> 2) + 4 * hi; }
__device__ __forceinline__ float wave_sum(float v) {
#pragma unroll
    for (int o = 1; o < 64; o <<= 1) v += __shfl_xor(v, o);
    return v;
}

namespace pg8 {
#define PG8_LAS __attribute__((address_space(3)))
typedef unsigned short bf16_t;
typedef short bf16x8 __attribute__((ext_vector_type(8)));
typedef float f32x4 __attribute__((ext_vector_type(4)));
typedef unsigned u32x4 __attribute__((ext_vector_type(4)));
constexpr int BM = 256, BK = 64, HALF = 128, HTB = HALF * BK * 2  , STAGE_BYTES = 8 * HTB, NXCD = 8, WGM = 8;

__host__ __device__ __forceinline__ int lds_byte(int r, int c) { const int st = (r >> 4) * 2 + (c >> 5), rr = r & 15, cc = c & 31, ob = rr * 64 + cc * 2; return st * 1024 + (ob ^ (((ob >> 9) & 1) << 5)); }
__host__ __device__ __forceinline__ void stage_rc(int b, int& R, int& C) { const int st = b / 1024, sb = b % 1024, swz = sb ^ (((sb >> 9) & 1) << 5); R = (st >> 1) * 16 + swz / 64; C = (st & 1) * 32 + (swz % 64) / 2; }
__host__ __device__ __forceinline__ int perm32(int rho) { const int n = rho >> 4, i = rho & 15; return 8 * (i >> 2) + 4 * n + (i & 3); }

struct Unit { int pm, pn; };
struct Gemm { const bf16_t* A; const bf16_t* Bt; int M, N, K; };

struct StaticOrder {
    int nM, nN, nwg, G, c;
    __host__ __device__ void init(int M, int N, int G_, int c_) { nM = M / BM; nN = N / BM; nwg = nM * nN; G = G_; c = c_; }
    __host__ __device__ bool next(int i, Unit& u) const {
        const long L = (long)i * G + c; if (L >= nwg) return false;
        int wgid = (int)L; { const int q = nwg / NXCD, r = nwg % NXCD, xcd = wgid % NXCD, off = wgid / NXCD; wgid = (xcd < r ? xcd * (q + 1) : r * (q + 1) + (xcd - r) * q) + off; }
        const int nig = WGM * nN, gid = wgid / nig, fm = gid * WGM, gsz = (nM - fm) < WGM ? (nM - fm) : WGM;
        u.pm = fm + ((wgid % nig) % gsz); u.pn = (wgid % nig) / gsz; return true;
    }
    __device__ __forceinline__ void a_ready(const Unit&) const {}
    __device__ __forceinline__ void done(const Unit&) const {}
};

__device__ __forceinline__ unsigned cvt_pk_bf16(float lo, float hi) { unsigned r; asm volatile("v_cvt_pk_bf16_f32 %0, %1, %2" : "=v"(r) : "v"(lo), "v"(hi)); return r; }
typedef float f32x2 __attribute__((ext_vector_type(2)));
__device__ __forceinline__ f32x4 silu4(f32x4 v) { f32x4 o; o.x = silu_f(v.x); o.y = silu_f(v.y); o.z = silu_f(v.z); o.w = silu_f(v.w); return o; }
struct PgEpiIn {
    static constexpr bool PERM = true, AFTER_DRAIN = false, MID = false; static constexpr int MID_T = 0;
    bf16_t* QH; float* ZF; bf16_t* IV; bf16_t* GH; float* AQKV; const float* LB;
    __device__ __forceinline__ void mid(f32x4 (&)[2][2][4][2], const Unit&, int, int) const {}
    __device__ __forceinline__ void operator()(const f32x4 (&acc)[2][2][4][2], const Unit& u, int wr, int wc, int fr, int fq) const {
        const int row0 = u.pm * BM + wr * 64 + fr, pn = u.pn, cw = wc * 32 + 8 * fq;
        if (pn < 2 || (pn >= 6 && pn < 10)) {
            bf16_t* base; int colt; bool act;
            if (pn < 2) { base = QH; colt = pn * 256; act = true; } else if (pn < 8) { base = IV; colt = (pn - 6) * 256; act = false; } else { base = GH; colt = (pn - 8) * 256; act = true; }
#pragma unroll
            for (int ai = 0; ai < 2; ++ai)
#pragma unroll
                for (int m = 0; m < 4; ++m) { bf16_t* rowp = base + (size_t)(row0 + ai * HALF + m * 16) * 512 + colt + cw;
#pragma unroll
                    for (int bj = 0; bj < 2; ++bj) { f32x4 v0 = acc[ai][bj][m][0], v1 = acc[ai][bj][m][1]; if (act) { v0 = silu4(v0); v1 = silu4(v1); }
                        u32x4 w; w.x = cvt_pk_bf16(v0[0], v0[1]); w.y = cvt_pk_bf16(v0[2], v0[3]); w.z = cvt_pk_bf16(v1[0], v1[1]); w.w = cvt_pk_bf16(v1[2], v1[3]);
                        *(u32x4*)(rowp + bj * HALF) = w; } }
        } else if (pn < 6) {
            const int colt = (pn - 2) * 256; f32x4 lb[2][2];
#pragma unroll
            for (int bj = 0; bj < 2; ++bj)
#pragma unroll
                for (int n = 0; n < 2; ++n) lb[bj][n] = *(const f32x4*)(LB + colt + bj * HALF + cw + 4 * n);
#pragma unroll
            for (int ai = 0; ai < 2; ++ai)
#pragma unroll
                for (int m = 0; m < 4; ++m) { float* rowp = ZF + (size_t)(row0 + ai * HALF + m * 16) * 1024 + colt + cw;
#pragma unroll
                    for (int bj = 0; bj < 2; ++bj)
#pragma unroll
                        for (int n = 0; n < 2; ++n) { const f32x4 v = acc[ai][bj][m][n], l = lb[bj][n]; f32x4 f;
                            f.x = l.x + (1.f - l.x) * sigmoid_f(v.x); f.y = l.y + (1.f - l.y) * sigmoid_f(v.y); f.z = l.z + (1.f - l.z) * sigmoid_f(v.z); f.w = l.w + (1.f - l.w) * sigmoid_f(v.w);
                            *(f32x4*)(rowp + bj * HALF + 4 * n) = f; } }
        } else {
            const int colt = (pn - 10) * 256;
#pragma unroll
            for (int ai = 0; ai < 2; ++ai)
#pragma unroll
                for (int m = 0; m < 4; ++m) { float* rowp = AQKV + (size_t)(row0 + ai * HALF + m * 16) * 768 + colt + cw;
#pragma unroll
                    for (int bj = 0; bj < 2; ++bj)
#pragma unroll
                        for (int n = 0; n < 2; ++n) *(f32x4*)(rowp + bj * HALF + 4 * n) = acc[ai][bj][m][n]; }
        }
    }
};
struct PgEpiOut {
    static constexpr bool PERM = true, AFTER_DRAIN = false, MID = true; static constexpr int MID_T = 8;
    const float* x; float* out; bf16_t* XB; float* ss2; const float* ssatt;
    __device__ __forceinline__ void mid(f32x4 (&acc)[2][2][4][2], const Unit& u, int wr, int fr) const {
#pragma unroll
        for (int ai = 0; ai < 2; ++ai)
#pragma unroll
            for (int m = 0; m < 4; ++m) { const float s = 1.f / sqrtf(ssatt[u.pm * BM + ai * HALF + wr * 64 + m * 16 + fr] * (1.f / 512.f) + EPS);
#pragma unroll
                for (int bj = 0; bj < 2; ++bj)
#pragma unroll
                    for (int n = 0; n < 2; ++n) acc[ai][bj][m][n] *= s; }
    }
    __device__ __forceinline__ void operator()(const f32x4 (&acc)[2][2][4][2], const Unit& u, int wr, int wc, int fr, int fq) const {
#pragma unroll
        for (int ai = 0; ai < 2; ++ai)
#pragma unroll
            for (int m = 0; m < 4; ++m) { const int row = u.pm * BM + ai * HALF + wr * 64 + m * 16 + fr; float q = 0.f;
#pragma unroll
                for (int bj = 0; bj < 2; ++bj) { const size_t idx = (size_t)row * D + u.pn * BM + bj * HALF + wc * 32 + 8 * fq;
                    const f32x4 v0 = *(const f32x4*)(x + idx) + acc[ai][bj][m][0], v1 = *(const f32x4*)(x + idx + 4) + acc[ai][bj][m][1];
                    *(f32x4*)(out + idx) = v0; *(f32x4*)(out + idx + 4) = v1;
                    u32x4 w; w.x = cvt_pk_bf16(v0[0], v0[1]); w.y = cvt_pk_bf16(v0[2], v0[3]); w.z = cvt_pk_bf16(v1[0], v1[1]); w.w = cvt_pk_bf16(v1[2], v1[3]);
                    *(u32x4*)(XB + idx) = w;
                    q += (v0[0] * v0[0] + v0[1] * v0[1]) + (v0[2] * v0[2] + v0[3] * v0[3]) + (v1[0] * v1[0] + v1[1] * v1[1]) + (v1[2] * v1[2] + v1[3] * v1[3]); }
                q += __shfl_xor(q, 16); q += __shfl_xor(q, 32);
                if (fq == 0) atomicAdd(ss2 + row, q); }
    }
};
struct PgEpiGU {
    static constexpr bool PERM = true, AFTER_DRAIN = false, MID = false; static constexpr int MID_T = 0;
    bf16_t* H; const float* ss2;
    __device__ __forceinline__ void mid(f32x4 (&)[2][2][4][2], const Unit&, int, int) const {}
    __device__ __forceinline__ void operator()(const f32x4 (&acc)[2][2][4][2], const Unit& u, int wr, int wc, int fr, int fq) const {
#pragma unroll
        for (int ai = 0; ai < 2; ++ai)
#pragma unroll
            for (int m = 0; m < 4; ++m) { const int row = u.pm * BM + ai * HALF + wr * 64 + m * 16 + fr; const float s = 1.f / sqrtf(ss2[row] * (1.f / D) + EPS);
                const f32x4 a0 = silu4(acc[ai][0][m][0] * s) * (acc[ai][1][m][0] * s), a1 = silu4(acc[ai][0][m][1] * s) * (acc[ai][1][m][1] * s);
                u32x4 w; w.x = cvt_pk_bf16(a0[0], a0[1]); w.y = cvt_pk_bf16(a0[2], a0[3]); w.z = cvt_pk_bf16(a1[0], a1[1]); w.w = cvt_pk_bf16(a1[2], a1[3]);
                *(u32x4*)(H + (size_t)row * DFF + 128 * u.pn + wc * 32 + 8 * fq) = w; }
    }
};
struct PgEpiDown {
    static constexpr bool PERM = true, AFTER_DRAIN = false, MID = false; static constexpr int MID_T = 0;
    float* out; float* ss3;
    __device__ __forceinline__ void mid(f32x4 (&)[2][2][4][2], const Unit&, int, int) const {}
    __device__ __forceinline__ void operator()(const f32x4 (&acc)[2][2][4][2], const Unit& u, int wr, int wc, int fr, int fq) const {
#pragma unroll
        for (int ai = 0; ai < 2; ++ai)
#pragma unroll
            for (int m = 0; m < 4; ++m) { const int row = u.pm * BM + ai * HALF + wr * 64 + m * 16 + fr; float q = 0.f;
#pragma unroll
                for (int bj = 0; bj < 2; ++bj) { const size_t idx = (size_t)row * D + u.pn * BM + bj * HALF + wc * 32 + 8 * fq;
                    const f32x4 v0 = *(const f32x4*)(out + idx) + acc[ai][bj][m][0], v1 = *(const f32x4*)(out + idx + 4) + acc[ai][bj][m][1];
                    *(f32x4*)(out + idx) = v0; *(f32x4*)(out + idx + 4) = v1;
                    q += (v0[0] * v0[0] + v0[1] * v0[1]) + (v0[2] * v0[2] + v0[3] * v0[3]) + (v1[0] * v1[0] + v1[1] * v1[1]) + (v1[2] * v1[2] + v1[3] * v1[3]); }
                q += __shfl_xor(q, 16); q += __shfl_xor(q, 32);
                if (fq == 0) atomicAdd(ss3 + row, q); }
    }
};
template <class Epi, class Sched, bool ALIGN_EPI = false, bool SP2 = false>
__device__ __forceinline__ void gemm_phase(PG8_LAS unsigned char* lds, const Gemm g, const Sched& S, const Epi& E) {
    const int tid = threadIdx.x, wid = __builtin_amdgcn_readfirstlane(tid >> 6), lane = tid & 63, wr = wid >> 2, wc = wid & 3, fr = lane & 15, fq = lane >> 4;
    const int K = g.K, nt = K / BK;
    unsigned voffA[2], voffB[2];
#pragma unroll
    for (int i = 0; i < 2; ++i) { int R, C; stage_rc(tid * 16 + i * 8192, R, C); const int Rb = Epi::PERM ? ((R & ~31) + perm32(R & 31)) : R;
        voffA[i] = (unsigned)(R * K + C) * 2u; voffB[i] = (unsigned)(Rb * K + C) * 2u; }
    const size_t kstep = (size_t)(BK * 2);
    const size_t hstep = (size_t)HALF * K * 2;
    const size_t tstep = 2 * hstep;
    const unsigned ldsw = (unsigned)wid * 1024u;
    const int aoff = lds_byte(wr * 64 + fr, fq * 8), boff = lds_byte(wc * 32 + fr, fq * 8);
#define PG8_SA(b, h) (((b) * 2 + (h)) * HTB)
#define PG8_SB(b, h) ((4 + (b) * 2 + (h)) * HTB)
#define PG8_STAGE(bufoff, gbase, voff) do { _Pragma("unroll") for (int _i = 0; _i < 2; ++_i) \
        __builtin_amdgcn_global_load_lds((const unsigned*)((const char*)(gbase) + (voff)[_i]), (PG8_LAS unsigned*)(lds + (bufoff) + ldsw + _i * 8192), 16, 0, 0); } while (0)
#define PG8_LDA(dst, b, h) do { _Pragma("unroll") for (int m = 0; m < 4; ++m) _Pragma("unroll") for (int k = 0; k < 2; ++k) dst[m][k] = *(const PG8_LAS bf16x8*)(lds + PG8_SA(b, h) + aoff + m * 2048 + k * 1024); } while (0)
#define PG8_LDB(dst, b, h) do { _Pragma("unroll") for (int n = 0; n < 2; ++n) _Pragma("unroll") for (int k = 0; k < 2; ++k) dst[n][k] = *(const PG8_LAS bf16x8*)(lds + PG8_SB(b, h) + boff + n * 2048 + k * 1024); } while (0)
#define PG8_MMA(ai, bj, At, Bt) do { __builtin_amdgcn_s_setprio(1); _Pragma("unroll") for (int m = 0; m < 4; ++m) _Pragma("unroll") for (int n = 0; n < 2; ++n) _Pragma("unroll") for (int k = 0; k < 2; ++k) \
        acc[ai][bj][m][n] = __builtin_amdgcn_mfma_f32_16x16x32_bf16(Bt[n][k], At[m][k], acc[ai][bj][m][n], 0, 0, 0); __builtin_amdgcn_s_setprio(0); } while (0)
#define PG8_WAIT_V(n) asm volatile("s_waitcnt vmcnt(" #n ")" ::: "memory")
#define PG8_WAIT_L(n) asm volatile("s_waitcnt lgkmcnt(" #n ")" ::: "memory")
#define PG8_BAR __builtin_amdgcn_s_barrier()
#define PG8_SCHED __builtin_amdgcn_sched_barrier(0)
    Unit cur, nxt; int ui = 0;
    if (!S.next(0, cur)) return;
    f32x4 acc[2][2][4][2];
#pragma unroll
    for (int a = 0; a < 2; ++a)
#pragma unroll
        for (int b = 0; b < 2; ++b)
#pragma unroll
            for (int m = 0; m < 4; ++m)
#pragma unroll
                for (int n = 0; n < 2; ++n) acc[a][b][m][n] = (f32x4){0.f, 0.f, 0.f, 0.f};
    bf16x8 At[4][2], B0[2][2], B1[2][2];
    const char* cA = (const char*)g.A + (size_t)cur.pm * tstep; const char* cB = (const char*)g.Bt + (size_t)cur.pn * tstep;
    S.a_ready(cur);
    if constexpr (SP2) {
        PG8_STAGE(PG8_SB(0, 0), cB, voffB); PG8_STAGE(PG8_SB(0, 1), cB + hstep, voffB); PG8_STAGE(PG8_SA(0, 0), cA, voffA); PG8_STAGE(PG8_SA(0, 1), cA + hstep, voffA);
        if (wr == 1) PG8_BAR;
        PG8_WAIT_V(2); PG8_BAR;
        PG8_STAGE(PG8_SB(1, 0), cB + kstep, voffB); PG8_STAGE(PG8_SA(1, 0), cA + kstep, voffA); PG8_STAGE(PG8_SB(1, 1), cB + hstep + kstep, voffB);
        PG8_WAIT_V(6); PG8_BAR;
    } else {
        PG8_STAGE(PG8_SB(0, 0), cB, voffB); PG8_STAGE(PG8_SA(0, 0), cA, voffA); PG8_STAGE(PG8_SB(0, 1), cB + hstep, voffB); PG8_STAGE(PG8_SA(0, 1), cA + hstep, voffA);
        if (wr == 1) PG8_BAR;
        PG8_WAIT_V(4); PG8_BAR;
        PG8_STAGE(PG8_SB(1, 0), cB + kstep, voffB); PG8_STAGE(PG8_SA(1, 0), cA + kstep, voffA); PG8_STAGE(PG8_SB(1, 1), cB + hstep + kstep, voffB);
        PG8_WAIT_V(6); PG8_BAR;
    }
    for (;;) {
        const bool has_next = S.next(ui + 1, nxt);
        const char* nA = has_next ? (const char*)g.A + (size_t)nxt.pm * tstep : cA; const char* nB = has_next ? (const char*)g.Bt + (size_t)nxt.pn * tstep : cB;
        for (int t = 0; t < nt; t += 2) {
            const bool last = (t == nt - 2);
            if constexpr (Epi::MID) { if (t == Epi::MID_T) E.mid(acc, cur, wr, fr); }
            const char* a1 = cA + (size_t)(t + 1) * kstep;
            const char* a2 = last ? nA : cA + (size_t)(t + 2) * kstep; const char* b2 = last ? nB : cB + (size_t)(t + 2) * kstep;
            const char* a3 = a2 + kstep; const char* b3 = b2 + kstep;
            if (last && has_next) S.a_ready(nxt);
            if constexpr (SP2) {
            PG8_LDB(B0, 0, 0); PG8_LDB(B1, 0, 1); PG8_SCHED; PG8_LDA(At, 0, 0); PG8_STAGE(PG8_SA(1, 1), a1 + hstep, voffA);
            PG8_WAIT_V(8); PG8_WAIT_L(0); PG8_BAR; PG8_MMA(0, 0, At, B0); PG8_MMA(0, 1, At, B1); PG8_BAR; PG8_SCHED;
            PG8_LDA(At, 0, 1); PG8_STAGE(PG8_SB(0, 0), b2, voffB); PG8_STAGE(PG8_SB(0, 1), b2 + hstep, voffB); PG8_STAGE(PG8_SA(0, 0), a2, voffA);
            PG8_WAIT_V(8); PG8_WAIT_L(0); PG8_BAR; PG8_MMA(1, 0, At, B0); PG8_MMA(1, 1, At, B1); PG8_BAR; PG8_SCHED;
            PG8_LDB(B0, 1, 0); PG8_LDB(B1, 1, 1); PG8_SCHED; PG8_LDA(At, 1, 0); PG8_STAGE(PG8_SA(0, 1), a2 + hstep, voffA);
            PG8_WAIT_V(8); PG8_WAIT_L(0); PG8_BAR; PG8_MMA(0, 0, At, B0); PG8_MMA(0, 1, At, B1); PG8_BAR; PG8_SCHED;
            PG8_LDA(At, 1, 1); PG8_STAGE(PG8_SB(1, 0), b3, voffB); PG8_STAGE(PG8_SB(1, 1), b3 + hstep, voffB); PG8_STAGE(PG8_SA(1, 0), a3, voffA);
            PG8_WAIT_V(8); PG8_WAIT_L(0); PG8_BAR; PG8_MMA(1, 0, At, B0); PG8_MMA(1, 1, At, B1); PG8_BAR; PG8_SCHED;
            } else {
            PG8_LDB(B0, 0, 0); PG8_SCHED; PG8_LDA(At, 0, 0); PG8_STAGE(PG8_SA(1, 1), a1 + hstep, voffA);
            PG8_WAIT_L(8); PG8_BAR; PG8_WAIT_L(0); PG8_MMA(0, 0, At, B0); PG8_BAR; PG8_SCHED;
            PG8_LDB(B1, 0, 1); PG8_STAGE(PG8_SB(0, 0), b2, voffB);
            PG8_BAR; PG8_WAIT_L(0); PG8_MMA(0, 1, At, B1); PG8_BAR;
            PG8_LDA(At, 0, 1); PG8_STAGE(PG8_SA(0, 0), a2, voffA);
            PG8_BAR; PG8_WAIT_L(0); PG8_MMA(1, 0, At, B0); PG8_BAR; PG8_SCHED;
            PG8_STAGE(PG8_SB(0, 1), b2 + hstep, voffB);
            PG8_WAIT_V(6); PG8_BAR; PG8_MMA(1, 1, At, B1); PG8_BAR;
            PG8_LDB(B0, 1, 0); PG8_SCHED; PG8_LDA(At, 1, 0); PG8_STAGE(PG8_SA(0, 1), a2 + hstep, voffA);
            PG8_WAIT_L(8); PG8_BAR; PG8_WAIT_L(0); PG8_MMA(0, 0, At, B0); PG8_BAR; PG8_SCHED;
            PG8_LDB(B1, 1, 1); PG8_STAGE(PG8_SB(1, 0), b3, voffB);
            PG8_BAR; PG8_WAIT_L(0); PG8_MMA(0, 1, At, B1); PG8_BAR;
            PG8_LDA(At, 1, 1); PG8_STAGE(PG8_SA(1, 0), a3, voffA);
            PG8_BAR; PG8_WAIT_L(0); PG8_MMA(1, 0, At, B0); PG8_BAR; PG8_SCHED;
            PG8_STAGE(PG8_SB(1, 1), b3 + hstep, voffB);
            PG8_WAIT_V(6); PG8_BAR; PG8_MMA(1, 1, At, B1); PG8_BAR;
            }
        }
        if constexpr (ALIGN_EPI) { if (wr == 0) PG8_BAR; }
        if constexpr (!Epi::AFTER_DRAIN) { E(acc, cur, wr, wc, fr, fq); S.done(cur); }
        if (!has_next) break;
#pragma unroll
        for (int a = 0; a < 2; ++a)
#pragma unroll
            for (int b = 0; b < 2; ++b)
#pragma unroll
                for (int m = 0; m < 4; ++m)
#pragma unroll
                    for (int n = 0; n < 2; ++n) acc[a][b][m][n] = (f32x4){0.f, 0.f, 0.f, 0.f};
        cur = nxt; cA = nA; cB = nB; ++ui;
        if constexpr (ALIGN_EPI) { if (wr == 1) PG8_BAR; }
    }
    PG8_WAIT_V(0);
    if constexpr (!ALIGN_EPI) { if (wr == 0) PG8_BAR; }
    PG8_BAR;
    if constexpr (Epi::AFTER_DRAIN) { E.fused(acc, cur, wr, wc, fr, fq, lds, wid, lane); S.done(cur); }
#undef PG8_SA
#undef PG8_SB
#undef PG8_STAGE
#undef PG8_LDA
#undef PG8_LDB
#undef PG8_MMA
#undef PG8_WAIT_V
#undef PG8_WAIT_L
#undef PG8_BAR
#undef PG8_SCHED
}
}

__device__ __forceinline__ void transpose_item(const float* W, int N, bf16_t* WT, int Kd, int k_src0, int k_dst0, int n_src0, int n_dst0, const float* sc, LAS float* scr, int lane) {
#pragma unroll 8
    for (int i = 0; i < 32; ++i) { const int kk = 2 * i + (lane >> 5); float v = W[(size_t)(k_src0 + kk) * N + n_src0 + (lane & 31)]; if (sc) v *= sc[k_src0 + kk]; scr[kk * 33 + (lane & 31)] = v; }
    asm volatile("s_waitcnt lgkmcnt(0)" ::: "memory");
    const int c = lane & 7;
#pragma unroll
    for (int j = 0; j < 4; ++j) { const int n = (lane >> 3) + 8 * j; const LAS float* s = scr + (8 * c) * 33 + n;
        u32x4 o; o.x = pk2(s[0 * 33], s[1 * 33]); o.y = pk2(s[2 * 33], s[3 * 33]); o.z = pk2(s[4 * 33], s[5 * 33]); o.w = pk2(s[6 * 33], s[7 * 33]);
        *(u32x4*)(WT + (size_t)(n_dst0 + n) * Kd + k_dst0 + 8 * c) = o; }
    asm volatile("s_waitcnt lgkmcnt(0)" ::: "memory");
}

__device__ __forceinline__ void p0_prologue(const Params& p, LAS unsigned char* lds, int bid, int nb) {
    const int tid = threadIdx.x, lane = tid & 63, wave = tid >> 6;
    LAS float* scr = (LAS float*)(lds + wave * 16384);
    const int gw = bid * NWAVES + wave, NGW = nb * NWAVES;
    bf16_t* Win_t = (bf16_t*)(p.ws + WS_WIN); bf16_t* Wout_t = (bf16_t*)(p.ws + WS_WOUT); bf16_t* Wgu_t = (bf16_t*)(p.ws + WS_WGU); bf16_t* Wdn_t = (bf16_t*)(p.ws + WS_WDN);
    constexpr int I_IN = (D / 64) * (DIN / 32), I_OUT = (D / 64) * (D / 32), I_GU = (D / 64) * (2 * DFF / 32), I_DN = (DFF / 64) * (D / 32);
    constexpr int NITEMS = I_IN + I_OUT + I_GU + I_DN;
    for (int it = gw; it < NITEMS; it += NGW) {
        int r = it;
        if (r < I_IN) { const int nblk = DIN / 32, kb = r / nblk, nbk = r % nblk; transpose_item(p.w_in, DIN, Win_t, D, 64 * kb, 64 * kb, 32 * nbk, 32 * nbk, nullptr, scr, lane); continue; } r -= I_IN;
        if (r < I_OUT) { const int nblk = D / 32, kb = r / nblk, nbk = r % nblk; const int ks = 64 * kb;
            transpose_item(p.w_out, D, Wout_t, D, ks, (ks + 512) & 1023, 32 * nbk, 32 * nbk, ks >= 512 ? p.att_norm_w - 512 : nullptr, scr, lane); continue; } r -= I_OUT;
        if (r < I_GU) { const int nblk = 2 * DFF / 32, kb = r / nblk, nbk = r % nblk; const int nd = 32 * nbk, pn = nd >> 8, nn = nd & 255;
            const int ns = nn < 128 ? 128 * pn + nn : DFF + 128 * pn + nn - 128;
            transpose_item(p.w_gate_up, 2 * DFF, Wgu_t, D, 64 * kb, 64 * kb, ns, nd, p.norm2_w, scr, lane); continue; } r -= I_GU;
        { const int nblk = D / 32, kb = r / nblk, nbk = r % nblk; transpose_item(p.w_down, D, Wdn_t, DFF, 64 * kb, 64 * kb, 32 * nbk, 32 * nbk, nullptr, scr, lane); }
    }
    bf16_t* XN = (bf16_t*)(p.ws + WS_XN);
    for (int m = gw; m < M; m += NGW) {
        const f32x4* xr = (const f32x4*)(p.x + (size_t)m * D) + lane; const f32x4* wr = (const f32x4*)p.norm1_w + lane;
        f32x4 v[4]; float s = 0.f;
#pragma unroll
        for (int j = 0; j < 4; ++j) { v[j] = xr[64 * j]; s += (v[j].x * v[j].x + v[j].y * v[j].y) + (v[j].z * v[j].z + v[j].w * v[j].w); }
        const float rstd = 1.f / sqrtf(wave_sum(s) * (1.f / D) + EPS);
        unsigned long long* o8 = (unsigned long long*)(XN + (size_t)m * D) + lane;
#pragma unroll
        for (int j = 0; j < 4; ++j) { const f32x4 w = wr[64 * j]; o8[64 * j] = (unsigned long long)pk2(v[j].x * rstd * w.x, v[j].y * rstd * w.y) | ((unsigned long long)pk2(v[j].z * rstd * w.z, v[j].w * rstd * w.w) << 32); }
    }
    if (bid == 0) { float* LB = (float*)(p.ws + WS_CTL + CTL_LB);
        for (int j = tid; j < 1024; j += NTHREADS) { const int d = j >> 9, jj = j & 511; const float a0 = p.lb_logits[d * 1024 + jj], a1 = p.lb_logits[d * 1024 + 512 + jj]; LB[j] = 1.f / (1.f + expf(a1 - a0)); } }
}

struct EpiIn {
    static constexpr bool PAIR = false, MID = false;
    bf16_t* QH; float* ZF; bf16_t* IV; bf16_t* GH; float* AQKV; const float* LB;
    __device__ __forceinline__ void elem(int row, int col, float v) const {
        if (col < 512) QH[(size_t)row * 512 + col] = (bf16_t)f2bf(silu_f(v));
        else if (col < 1536) { const int c = col - 512; const float lb = LB[c]; ZF[(size_t)row * 1024 + c] = lb + (1.f - lb) * sigmoid_f(v); }
        else if (col < 2048) IV[(size_t)row * 512 + col - 1536] = (bf16_t)f2bf(v);
        else if (col < 2560) GH[(size_t)row * 512 + col - 2048] = (bf16_t)f2bf(silu_f(v));
        else AQKV[(size_t)row * 768 + col - 2560] = v;
    }
    __device__ __forceinline__ void naive(f32x16 (&acc)[2][2], int row0, int col0, int cs, int r32, int hi) const {
#pragma unroll
        for (int i = 0; i < 2; ++i)
#pragma unroll
            for (int j = 0; j < 2; ++j)
#pragma unroll
                for (int r = 0; r < 16; ++r) elem(row0 + 32 * i + crow(r, hi), col0 + j * cs + r32, acc[i][j][r]);
    }
    __device__ __forceinline__ void mid(f32x16 (&)[2][2], int, int, int) const {}
};
struct EpiOut {
    static constexpr bool PAIR = false, MID = true; static constexpr int MIDK = 512;
    const float* x; float* out; bf16_t* XB; float* ss2; const float* ssatt;
    __device__ __forceinline__ void mid(f32x16 (&acc)[2][2], int row0, int r32, int hi) const {
#pragma unroll
        for (int i = 0; i < 2; ++i)
#pragma unroll
            for (int r = 0; r < 16; ++r) { const float s = 1.f / sqrtf(ssatt[row0 + 32 * i + crow(r, hi)] * (1.f / 512.f) + EPS); acc[i][0][r] *= s; acc[i][1][r] *= s; }
    }
    __device__ __forceinline__ void naive(f32x16 (&acc)[2][2], int row0, int col0, int cs, int r32, int hi) const {
#pragma unroll
        for (int i = 0; i < 2; ++i)
#pragma unroll
            for (int r = 0; r < 16; ++r) { const int row = row0 + 32 * i + crow(r, hi); float q = 0.f;
#pragma unroll
                for (int j = 0; j < 2; ++j) { const size_t idx = (size_t)row * D + col0 + j * cs + r32; const float v = x[idx] + acc[i][j][r]; out[idx] = v; XB[idx] = (bf16_t)f2bf(v); q += v * v; }
#pragma unroll
                for (int o = 1; o < 32; o <<= 1) q += __shfl_xor(q, o);
                if (r32 == 0) atomicAdd(ss2 + row, q); }
    }
};
struct EpiGU {
    static constexpr bool PAIR = true, MID = false;
    bf16_t* H; const float* ss2;
    __device__ __forceinline__ void naive(f32x16 (&acc)[2][2], int row0, int col0, int cs, int r32, int hi) const {
        const int pn = col0 >> 8, cc = (col0 & 255) + r32;
#pragma unroll
        for (int i = 0; i < 2; ++i)
#pragma unroll
            for (int r = 0; r < 16; ++r) { const int row = row0 + 32 * i + crow(r, hi); const float s = 1.f / sqrtf(ss2[row] * (1.f / D) + EPS);
                H[(size_t)row * DFF + 128 * pn + cc] = (bf16_t)f2bf(silu_f(acc[i][0][r] * s) * (acc[i][1][r] * s)); }
    }
    __device__ __forceinline__ void mid(f32x16 (&)[2][2], int, int, int) const {}
};
struct EpiDown {
    static constexpr bool PAIR = false, MID = false;
    float* out; float* ss3;
    __device__ __forceinline__ void naive(f32x16 (&acc)[2][2], int row0, int col0, int cs, int r32, int hi) const {
#pragma unroll
        for (int i = 0; i < 2; ++i)
#pragma unroll
            for (int r = 0; r < 16; ++r) { const int row = row0 + 32 * i + crow(r, hi); float q = 0.f;
#pragma unroll
                for (int j = 0; j < 2; ++j) { const size_t idx = (size_t)row * D + col0 + j * cs + r32; const float v = out[idx] + acc[i][j][r]; out[idx] = v; q += v * v; }
#pragma unroll
                for (int o = 1; o < 32; o <<= 1) q += __shfl_xor(q, o);
                if (r32 == 0) atomicAdd(ss3 + row, q); }
    }
    __device__ __forceinline__ void mid(f32x16 (&)[2][2], int, int, int) const {}
};

template <class Epi>
__device__ __forceinline__ void ngemm_phase(const bf16_t* A, const bf16_t* Bt, int M_, int N_, int K_, const Epi& E, int bid, int nb) {
    const int tid = threadIdx.x, lane = tid & 63, wid = tid >> 6, r32 = lane & 31, hi = lane >> 5, wr = wid >> 2, wc = wid & 3;
    const int nM = M_ / 128, nN = N_ / 256; constexpr int CS = Epi::PAIR ? 128 : 32;
    for (int u = bid; u < nM * nN; u += nb) {
        const int pm = u / nN, pn = u % nN;
        const int row0 = pm * 128 + wr * 64, col0 = pn * 256 + (Epi::PAIR ? wc * 32 : wc * 64);
        f32x16 acc[2][2];
#pragma unroll
        for (int i = 0; i < 2; ++i)
#pragma unroll
            for (int j = 0; j < 2; ++j)
#pragma unroll
                for (int r = 0; r < 16; ++r) acc[i][j][r] = 0.f;
        const bf16_t* a0 = A + (size_t)(row0 + r32) * K_ + hi * 8; const bf16_t* a1 = a0 + (size_t)32 * K_;
        const bf16_t* b0 = Bt + (size_t)(col0 + r32) * K_ + hi * 8; const bf16_t* b1 = b0 + (size_t)CS * K_;
        for (int k = 0; k < K_; k += 16) {
            if constexpr (Epi::MID) { if (k == Epi::MIDK) E.mid(acc, row0, r32, hi); }
            const bf16x8 fa0 = *(const bf16x8*)(a0 + k), fa1 = *(const bf16x8*)(a1 + k), fb0 = *(const bf16x8*)(b0 + k), fb1 = *(const bf16x8*)(b1 + k);
            acc[0][0] = __builtin_amdgcn_mfma_f32_32x32x16_bf16(fa0, fb0, acc[0][0], 0, 0, 0);
            acc[0][1] = __builtin_amdgcn_mfma_f32_32x32x16_bf16(fa0, fb1, acc[0][1], 0, 0, 0);
            acc[1][0] = __builtin_amdgcn_mfma_f32_32x32x16_bf16(fa1, fb0, acc[1][0], 0, 0, 0);
            acc[1][1] = __builtin_amdgcn_mfma_f32_32x32x16_bf16(fa1, fb1, acc[1][1], 0, 0, 0);
        }
        E.naive(acc, row0, col0, CS, r32, hi);
    }
}

__device__ __forceinline__ void rope_pair(float x1, float x2, int pi  , int t, float& o1, float& o2) {
    const int pos = pi < 16 ? (t >> 6) : (t & 63); const int fi = pi & 15;
    const float freq = exp2f(-(float)fi * (13.287712379549449f / 16.f));
    const float ang = (float)pos * freq; float rev = ang * 0.15915494309189535f; rev -= rintf(rev);
    const float s = __builtin_amdgcn_sinf(rev), c = __builtin_amdgcn_cosf(rev);
    o1 = x1 * c - x2 * s; o2 = x1 * s + x2 * c;
}
__device__ __forceinline__ void p2_qkconvert(const Params& p, int bid, int nb) {
    const int tid = threadIdx.x, lane = tid & 63, wave = tid >> 6; const int gw = bid * NWAVES + wave, NGW = nb * NWAVES;
    const float* AQKV = (const float*)(p.ws + WS_AQKV); bf16_t* QA = (bf16_t*)(p.ws + WS_QA); bf16_t* KA = (bf16_t*)(p.ws + WS_KA); bf16_t* VA = (bf16_t*)(p.ws + WS_VA); bf16_t* VT = (bf16_t*)(p.ws + WS_VT);
    const int pi = lane & 31;
    const f32x2 qw = *((const f32x2*)p.q_norm_w + pi), kw = *((const f32x2*)p.k_norm_w + pi);
    for (int m = gw; m < M; m += NGW) {
        const int t = m & (SEQ - 1), b = m >> 13; const float* row = AQKV + (size_t)m * 768;
#pragma unroll
        for (int j = 0; j < 4; ++j) {
            const f32x2 v = *((const f32x2*)row + 64 * j + lane); float ss = v.x * v.x + v.y * v.y;
#pragma unroll
            for (int o = 1; o < 32; o <<= 1) ss += __shfl_xor(ss, o);
            const float rstd = 1.f / sqrtf(ss * (1.f / 64.f) + EPS); float o1, o2; rope_pair(v.x * rstd * qw.x, v.y * rstd * qw.y, pi, t, o1, o2);
            *((unsigned*)(QA + (size_t)m * 512) + 64 * j + lane) = pk2(o1 * C2, o2 * C2);
        }
        {
            const f32x2 v = *((const f32x2*)(row + 512) + lane); float ss = v.x * v.x + v.y * v.y;
#pragma unroll
            for (int o = 1; o < 32; o <<= 1) ss += __shfl_xor(ss, o);
            const float rstd = 1.f / sqrtf(ss * (1.f / 64.f) + EPS); float o1, o2; rope_pair(v.x * rstd * kw.x, v.y * rstd * kw.y, pi, t, o1, o2);
            *((unsigned*)(KA + (size_t)m * 128) + lane) = pk2(o1, o2);
        }
        {
            const f32x2 v = *((const f32x2*)(row + 640) + lane); const unsigned w = pk2(v.x, v.y);
            *((unsigned*)(VA + (size_t)m * 128) + lane) = w;
            const int kvh = lane >> 5, d = 2 * (lane & 31);
            bf16_t* vt = VT + ((size_t)(b * 2 + kvh) * 64 + d) * SEQ + t; vt[0] = (bf16_t)(w & 0xffffu); vt[SEQ] = (bf16_t)(w >> 16);
        }
    }
}

__device__ __forceinline__ void nattn_unit(const bf16_t* QA, const bf16_t* KA, const bf16_t* VT, bf16_t* MIX, float* ssatt, int wu, int lane) {
    const int r32 = lane & 31, hi = lane >> 5; const int b = wu >> 11, hq = (wu >> 8) & 7, qb = wu & 255, kvh = hq >> 2;
    const size_t rowbase = (size_t)b * SEQ;
    const bf16_t* Qp = QA + (rowbase + qb * 32 + r32) * 512 + hq * 64 + hi * 8;
    bf16x8 qf[4];
#pragma unroll
    for (int d0 = 0; d0 < 4; ++d0) qf[d0] = *(const bf16x8*)(Qp + d0 * 16);
    const bf16_t* Kp = KA + (rowbase + r32) * 128 + kvh * 64 + hi * 8;
    const bf16_t* Vp = VT + ((size_t)(b * 2 + kvh) * 64 + r32) * SEQ + 4 * hi;
    f32x16 o0, o1;
#pragma unroll
    for (int r = 0; r < 16; ++r) { o0[r] = 0.f; o1[r] = 0.f; }
    float mrun = -1e30f, l = 0.f;
    for (int kv0 = 0; kv0 < SEQ; kv0 += 32) {
        f32x16 s;
#pragma unroll
        for (int r = 0; r < 16; ++r) s[r] = 0.f;
#pragma unroll
        for (int d0 = 0; d0 < 4; ++d0) { const bf16x8 kf = *(const bf16x8*)(Kp + (size_t)kv0 * 128 + d0 * 16); s = __builtin_amdgcn_mfma_f32_32x32x16_bf16(kf, qf[d0], s, 0, 0, 0); }
        float mx = s[0];
#pragma unroll
        for (int r = 1; r < 16; ++r) mx = fmaxf(mx, s[r]);
        mx = fmaxf(mx, __shfl_xor(mx, 32));
        const float mn = fmaxf(mrun, mx), alpha = __builtin_amdgcn_exp2f(mrun - mn); mrun = mn;
        float ps = 0.f;
#pragma unroll
        for (int r = 0; r < 16; ++r) { s[r] = __builtin_amdgcn_exp2f(s[r] - mn); ps += s[r]; }
        l = l * alpha + ps;
#pragma unroll
        for (int r = 0; r < 16; ++r) { o0[r] *= alpha; o1[r] *= alpha; }
#pragma unroll
        for (int si = 0; si < 2; ++si) {
            u32x4 pw; pw.x = pk2(s[8 * si + 0], s[8 * si + 1]); pw.y = pk2(s[8 * si + 2], s[8 * si + 3]); pw.z = pk2(s[8 * si + 4], s[8 * si + 5]); pw.w = pk2(s[8 * si + 6], s[8 * si + 7]);
            const bf16x8 pb = __builtin_bit_cast(bf16x8, pw);
            const bf16_t* vp = Vp + kv0 + 16 * si;
            { const bf16x4 lo = *(const bf16x4*)vp, h4 = *(const bf16x4*)(vp + 8); const bf16x8 vf = {lo[0], lo[1], lo[2], lo[3], h4[0], h4[1], h4[2], h4[3]}; o0 = __builtin_amdgcn_mfma_f32_32x32x16_bf16(vf, pb, o0, 0, 0, 0); }
            { const bf16_t* vq = vp + (size_t)32 * SEQ; const bf16x4 lo = *(const bf16x4*)vq, h4 = *(const bf16x4*)(vq + 8); const bf16x8 vf = {lo[0], lo[1], lo[2], lo[3], h4[0], h4[1], h4[2], h4[3]}; o1 = __builtin_amdgcn_mfma_f32_32x32x16_bf16(vf, pb, o1, 0, 0, 0); }
        }
    }
    l += __shfl_xor(l, 32); const float rl = 1.f / l; const size_t row = rowbase + qb * 32 + r32; float q = 0.f;
#pragma unroll
    for (int r = 0; r < 16; ++r) { const float a = o0[r] * rl, c = o1[r] * rl; q += a * a + c * c;
        MIX[row * 1024 + hq * 64 + crow(r, hi)] = (bf16_t)f2bf(a); MIX[row * 1024 + hq * 64 + 32 + crow(r, hi)] = (bf16_t)f2bf(c); }
    q += __shfl_xor(q, 32);
    if (hi == 0) atomicAdd(ssatt + row, q);
}

namespace hg {
constexpr int RS = 136, RS2 = 72, OLS = 132;
constexpr int QB_OFF = 0, QI_OFF = 17408, KI_OFF = 34816, KCT_OFF = 52224, VT_OFF = 70656, SPT_OFF = 89088, PP_OFF = 123904, SEGT_OFF = 133120, DEC_OFF = 135168, HG_LDS = 135680;
static_assert(HG_LDS <= LDS_BYTES && 64 * OLS * 4 <= KI_OFF, "hgrn lds map");
constexpr int NSC = 32;
#define HG_BAR() do { asm volatile("s_waitcnt vmcnt(0) lgkmcnt(0)" ::: "memory"); __builtin_amdgcn_s_barrier(); asm volatile("" ::: "memory"); } while (0)
#define HG_LD8(off, row, rs, col) (*(const LAS bf16x8*)(lds + (off) + ((row) * (rs) + (col)) * 2))

template <int DIR, bool OUT>
__device__ __forceinline__ void chunk_step(const Params& p, LAS unsigned char* lds, int b, int h, int chunk, f32x16 (&S)[2], f32x16& o, float& tsum) {
    const int tid = threadIdx.x, lane = tid & 63, wid = tid >> 6, r32 = lane & 31, hi = lane >> 5, c = tid & 127, seg = tid >> 7;
    const size_t r0 = (size_t)b * SEQ + chunk * 64 + seg * 16;
    const float* zf = (const float*)(p.ws + WS_ZF) + r0 * 1024 + DIR * 512 + h * 128 + c;
    const bf16_t* qh = (const bf16_t*)(p.ws + WS_QH) + r0 * 512 + h * 128 + c;
    const bf16_t* iv = (const bf16_t*)(p.ws + WS_IV) + r0 * 512 + h * 128 + c;
    LAS float* SEGT = (LAS float*)(lds + SEGT_OFF); LAS float* DEC = (LAS float*)(lds + DEC_OFF);
    float lf[16], kk[16], qv[16]; unsigned vraw[16];
#pragma unroll
    for (int j = 0; j < 16; ++j) { lf[j] = zf[(size_t)j * 1024]; vraw[j] = iv[(size_t)j * 512]; if (OUT) qv[j] = bf2f(qh[(size_t)j * 512]); }
#pragma unroll
    for (int j = 0; j < 16; ++j) { kk[j] = 1.f - lf[j]; lf[j] = __logf(lf[j]); }
    if (DIR == 0) {
#pragma unroll
        for (int j = 1; j < 16; ++j) lf[j] += lf[j - 1];
        SEGT[seg * 128 + c] = lf[15];
    } else {
#pragma unroll
        for (int j = 14; j >= 0; --j) lf[j] += lf[j + 1];
        SEGT[seg * 128 + c] = lf[0];
    }
    HG_BAR();
    const float t0 = SEGT[c], t1 = SEGT[128 + c], t2 = SEGT[256 + c], t3 = SEGT[384 + c];
    const float total = (t0 + t1) + (t2 + t3);
    const float off = DIR == 0 ? (seg == 0 ? 0.f : seg == 1 ? t0 : seg == 2 ? t0 + t1 : t0 + t1 + t2) : (seg == 3 ? 0.f : seg == 2 ? t3 : seg == 1 ? t2 + t3 : t1 + t2 + t3);
    const float bref = DIR == 0 ? t0 + t1 : t2 + t3;
    unsigned kcw[8], vw[8];
#pragma unroll
    for (int j = 0; j < 16; j += 2) {
        const float b0 = lf[j] + off, b1 = lf[j + 1] + off;
        kcw[j >> 1] = pk2(kk[j] * __expf(total - b0), kk[j + 1] * __expf(total - b1));
        vw[j >> 1] = vraw[j] | (vraw[j + 1] << 16);
        if (OUT) {
            const int row0 = (seg * 16 + j) * RS + c, row1 = row0 + RS;
            ((LAS bf16_t*)(lds + QB_OFF))[row0] = (bf16_t)f2bf(qv[j] * __expf(b0)); ((LAS bf16_t*)(lds + QB_OFF))[row1] = (bf16_t)f2bf(qv[j + 1] * __expf(b1));
            ((LAS bf16_t*)(lds + QI_OFF))[row0] = (bf16_t)f2bf(qv[j] * __expf(b0 - bref)); ((LAS bf16_t*)(lds + QI_OFF))[row1] = (bf16_t)f2bf(qv[j + 1] * __expf(b1 - bref));
            ((LAS bf16_t*)(lds + KI_OFF))[row0] = (bf16_t)f2bf(kk[j] * __expf(bref - b0)); ((LAS bf16_t*)(lds + KI_OFF))[row1] = (bf16_t)f2bf(kk[j + 1] * __expf(bref - b1));
        }
    }
    { LAS u32x4* kd = (LAS u32x4*)(lds + KCT_OFF + (c * RS2 + seg * 16) * 2); kd[0] = (u32x4){kcw[0], kcw[1], kcw[2], kcw[3]}; kd[1] = (u32x4){kcw[4], kcw[5], kcw[6], kcw[7]};
      LAS u32x4* vd = (LAS u32x4*)(lds + VT_OFF + (c * RS2 + seg * 16) * 2); vd[0] = (u32x4){vw[0], vw[1], vw[2], vw[3]}; vd[1] = (u32x4){vw[4], vw[5], vw[6], vw[7]}; }
    if (seg == 0) DEC[c] = __expf(total);
    tsum += total;
    const int cb = 2 * (wid >> 2), vb = wid & 3;
    if (OUT) {
#pragma unroll
        for (int i = 0; i < 2; ++i)
#pragma unroll
            for (int g = 0; g < 4; ++g) { u32x2 w; w.x = pk2(S[i][4 * g], S[i][4 * g + 1]); w.y = pk2(S[i][4 * g + 2], S[i][4 * g + 3]);
                *(LAS u32x2*)(lds + SPT_OFF + ((32 * vb + r32) * RS + 32 * (cb + i) + 8 * g + 4 * hi) * 2) = w; }
    }
    HG_BAR();
    if (OUT) {
        if (wid < 4) { const int tb = wid >> 1, sb = wid & 1; const bool skip = DIR == 0 ? (tb == 0 && sb == 1) : (tb == 1 && sb == 0);
            f32x16 sc;
#pragma unroll
            for (int r = 0; r < 16; ++r) sc[r] = 0.f;
            if (!skip) {
#pragma unroll
                for (int k8 = 0; k8 < 8; ++k8) sc = __builtin_amdgcn_mfma_f32_32x32x16_bf16(HG_LD8(QI_OFF, 32 * tb + r32, RS, 16 * k8 + 8 * hi), HG_LD8(KI_OFF, 32 * sb + r32, RS, 16 * k8 + 8 * hi), sc, 0, 0, 0);
            }
#pragma unroll
            for (int r = 0; r < 16; ++r) { const int t = 32 * tb + crow(r, hi), s = 32 * sb + r32; const bool keep = DIR == 0 ? s <= t : s >= t;
                ((LAS bf16_t*)(lds + PP_OFF))[t * RS2 + s] = keep ? (bf16_t)f2bf(sc[r]) : (bf16_t)0; }
        }
        HG_BAR();
        { const int tb = wid >> 2;
#pragma unroll
            for (int r = 0; r < 16; ++r) o[r] = 0.f;
#pragma unroll
            for (int k8 = 0; k8 < 8; ++k8) o = __builtin_amdgcn_mfma_f32_32x32x16_bf16(HG_LD8(QB_OFF, 32 * tb + r32, RS, 16 * k8 + 8 * hi), HG_LD8(SPT_OFF, 32 * vb + r32, RS, 16 * k8 + 8 * hi), o, 0, 0, 0);
#pragma unroll
            for (int k4 = 0; k4 < 4; ++k4) o = __builtin_amdgcn_mfma_f32_32x32x16_bf16(HG_LD8(PP_OFF, 32 * tb + r32, RS2, 16 * k4 + 8 * hi), HG_LD8(VT_OFF, 32 * vb + r32, RS2, 16 * k4 + 8 * hi), o, 0, 0, 0);
        }
    }
#pragma unroll
    for (int i = 0; i < 2; ++i) { const int c0 = 32 * (cb + i);
#pragma unroll
        for (int r = 0; r < 16; ++r) S[i][r] *= DEC[c0 + crow(r, hi)];
#pragma unroll
        for (int k4 = 0; k4 < 4; ++k4) S[i] = __builtin_amdgcn_mfma_f32_32x32x16_bf16(HG_LD8(KCT_OFF, c0 + r32, RS2, 16 * k4 + 8 * hi), HG_LD8(VT_OFF, 32 * vb + r32, RS2, 16 * k4 + 8 * hi), S[i], 0, 0, 0);
    }
}

template <int DIR>
__device__ __forceinline__ void pass1_unit(const Params& p, LAS unsigned char* lds, int b, int h, int sc) {
    const int tid = threadIdx.x, lane = tid & 63, wid = tid >> 6;
    f32x16 S[2]; f32x16 odummy; float tsum = 0.f;
#pragma unroll
    for (int i = 0; i < 2; ++i)
#pragma unroll
        for (int r = 0; r < 16; ++r) S[i][r] = 0.f;
    for (int ci = 0; ci < 4; ++ci) chunk_step<DIR, false>(p, lds, b, h, sc * 4 + (DIR ? 3 - ci : ci), S, odummy, tsum);
    const size_t seq = (size_t)((DIR * 2 + b) * 4 + h) * NSC + sc;
    float* send = (float*)(p.ws + WS_SEND) + seq * 16384;
#pragma unroll
    for (int i = 0; i < 2; ++i)
#pragma unroll
        for (int r = 0; r < 16; ++r) send[((wid * 2 + i) * 16 + r) * 64 + lane] = S[i][r];
    if (tid < 128) ((float*)(p.ws + WS_DTOT))[seq * 128 + tid] = __expf(tsum);
    HG_BAR();
}

__device__ __forceinline__ void scan_phase(const Params& p, int bid, int nb) {
    float* SEND = (float*)(p.ws + WS_SEND); const float* DTOT = (const float*)(p.ws + WS_DTOT);
    for (int idx = bid * NTHREADS + threadIdx.x; idx < 16 * 16384; idx += nb * NTHREADS) {
        const int sq = idx >> 14, e = idx & 16383, dir = sq >> 3; const int ln = e & 63, reg = (e >> 6) & 15, i = (e >> 10) & 1, w = e >> 11;
        const int c = 32 * (2 * (w >> 2) + i) + crow(reg, ln >> 5);
        float* base = SEND + (size_t)sq * NSC * 16384 + e; const float* dt = DTOT + (size_t)sq * NSC * 128 + c;
        float run = 0.f;
        if (dir == 0) { for (int sc = 0; sc < NSC; ++sc) { const float end = base[(size_t)sc * 16384]; base[(size_t)sc * 16384] = run; run = dt[sc * 128] * run + end; } }
        else { for (int sc = NSC - 1; sc >= 0; --sc) { const float end = base[(size_t)sc * 16384]; base[(size_t)sc * 16384] = run; run = dt[sc * 128] * run + end; } }
    }
}

__device__ __forceinline__ void pass2_unit(const Params& p, LAS unsigned char* lds, int b, int h, int sc) {
    const int tid = threadIdx.x, lane = tid & 63, wid = tid >> 6, r32 = lane & 31, hi = lane >> 5;
    f32x16 S[2]; float tsum = 0.f;
    unsigned* ofw = (unsigned*)(p.ws + WS_OFW) + (size_t)blockIdx.x * 16384 + wid * 512 + lane;
    { const float* send = (const float*)(p.ws + WS_SEND) + ((size_t)((0 * 2 + b) * 4 + h) * NSC + sc) * 16384;
#pragma unroll
      for (int i = 0; i < 2; ++i)
#pragma unroll
          for (int r = 0; r < 16; ++r) S[i][r] = send[((wid * 2 + i) * 16 + r) * 64 + lane]; }
#pragma unroll 1
    for (int ci = 0; ci < 4; ++ci) { f32x16 o; chunk_step<0, true>(p, lds, b, h, sc * 4 + ci, S, o, tsum);
#pragma unroll
        for (int k = 0; k < 8; ++k) ofw[ci * 4096 + k * 64] = pk2(o[2 * k], o[2 * k + 1]); }
    { const float* send = (const float*)(p.ws + WS_SEND) + ((size_t)((1 * 2 + b) * 4 + h) * NSC + sc) * 16384;
#pragma unroll
      for (int i = 0; i < 2; ++i)
#pragma unroll
          for (int r = 0; r < 16; ++r) S[i][r] = send[((wid * 2 + i) * 16 + r) * 64 + lane]; }
    const bf16_t* GH = (const bf16_t*)(p.ws + WS_GH); bf16_t* MIX = (bf16_t*)(p.ws + WS_MIX);
#pragma unroll 1
    for (int cj = 0; cj < 4; ++cj) { const int ci = 3 - cj; f32x16 o;
        chunk_step<1, true>(p, lds, b, h, sc * 4 + ci, S, o, tsum);
#pragma unroll
        for (int k = 0; k < 8; ++k) { const unsigned w = ofw[ci * 4096 + k * 64]; o[2 * k] += __builtin_bit_cast(float, w << 16); o[2 * k + 1] += __builtin_bit_cast(float, w & 0xffff0000u); }
        HG_BAR();
        LAS float* OL = (LAS float*)lds; const int tb = wid >> 2, vb = wid & 3;
#pragma unroll
        for (int r = 0; r < 16; ++r) OL[(32 * tb + crow(r, hi)) * OLS + 32 * vb + r32] = o[r];
        HG_BAR();
        { const int tt = tid >> 3, sg = tid & 7; const size_t row = (size_t)b * SEQ + (sc * 4 + ci) * 64 + tt; float tot[16]; float ss = 0.f;
#pragma unroll
          for (int j = 0; j < 16; j += 4) { const f32x4 v = *(const LAS f32x4*)(OL + tt * OLS + sg * 16 + j); tot[j] = v.x; tot[j + 1] = v.y; tot[j + 2] = v.z; tot[j + 3] = v.w; ss += (v.x * v.x + v.y * v.y) + (v.z * v.z + v.w * v.w); }
          ss += __shfl_xor(ss, 1); ss += __shfl_xor(ss, 2); ss += __shfl_xor(ss, 4);
          const float rstd = 1.f / sqrtf(ss * (1.f / 128.f) + EPS);
          const u32x4 g0 = *(const u32x4*)(GH + row * 512 + h * 128 + sg * 16), g1 = *(const u32x4*)(GH + row * 512 + h * 128 + sg * 16 + 8);
          const unsigned gw[8] = {g0.x, g0.y, g0.z, g0.w, g1.x, g1.y, g1.z, g1.w}; unsigned ow[8];
#pragma unroll
          for (int j = 0; j < 16; j += 2) { const float w0 = p.hg_norm_w[sg * 16 + j], w1 = p.hg_norm_w[sg * 16 + j + 1]; const unsigned g = gw[j >> 1];
              ow[j >> 1] = pk2(tot[j] * rstd * w0 * __builtin_bit_cast(float, g << 16), tot[j + 1] * rstd * w1 * __builtin_bit_cast(float, g & 0xffff0000u)); }
          u32x4* dst = (u32x4*)(MIX + row * 1024 + 512 + h * 128 + sg * 16); dst[0] = (u32x4){ow[0], ow[1], ow[2], ow[3]}; dst[1] = (u32x4){ow[4], ow[5], ow[6], ow[7]}; }
    }
    HG_BAR();
}
#undef HG_BAR
#undef HG_LD8
}

#include <hip/hip_bf16.h>
#include <cmath>
namespace attn_body {
using bf16=__hip_bfloat16;
using bf16x8=__attribute__((ext_vector_type(8)))short;
using s16x4=__attribute__((ext_vector_type(4)))short;
using f32x16=__attribute__((ext_vector_type(16)))float;
using u32x4=__attribute__((ext_vector_type(4)))unsigned;
constexpr int BATCH=2,NHEAD=8,NKV=2,SEQ=8192,D=64,QP=512,KP=128,OP=1024;
constexpr int NW=8,QBLK=32,QB=QBLK*NW,KVBLK=64,NQB=SEQ/QB;
constexpr int ATTN_UNIT_ROWS=QB;
__device__ __forceinline__ int crow(int r,int hi){return (r&3)+8*(r>>2)+4*hi;}
#define SBAR() __builtin_amdgcn_sched_barrier(0)
__device__ __forceinline__ void cmask(f32x16&p0,f32x16&p1,int jb,int qrel,int hi){
  const float NEG=-INFINITY; int kb=64*jb+4*hi;
  #pragma unroll
  for(int r=0;r<16;++r){int kv=kb+(r&3)+8*(r>>2); if(kv>qrel)p0[r]=NEG; if(kv+32>qrel)p1[r]=NEG;}
}

constexpr int NSLOT=3, SLOTB=8192;
constexpr int LDS_K=0, LDS_V=NSLOT*SLOTB, LDS_WS=2*NSLOT*SLOTB, LDS_OST=LDS_WS+NW*64*4, LDS_BYTES=LDS_OST+NW*4096;
constexpr float C2=0.125f*1.4426950408889634f;
__device__ __forceinline__ void glds16(const void*gsrc,unsigned lds_dst){unsigned keep;
  asm volatile("s_mov_b32 %0, m0\n\ts_mov_b32 m0, %2\n\ts_nop 0\n\tglobal_load_lds_dwordx4 %1, off\n\ts_mov_b32 m0, %0":"=&s"(keep):"v"(gsrc),"s"(lds_dst):"memory");}
__device__ __forceinline__ float max3f(float a,float b,float c){float r;asm("v_max3_f32 %0, %1, %2, %3":"=v"(r):"v"(a),"v"(b),"v"(c));return r;}
__device__ __forceinline__ float max2f(float a,float b){float r;asm("v_max_f32_e32 %0, %1, %2":"=v"(r):"v"(a),"v"(b));return r;}
__device__ __forceinline__ float fadd_s(float a,float b){float r;asm("v_add_f32_e32 %0, %1, %2":"=v"(r):"v"(a),"v"(b));return r;}
__device__ __forceinline__ float fsub_s(float a,float b){float r;asm("v_sub_f32_e32 %0, %1, %2":"=v"(r):"v"(a),"v"(b));return r;}
typedef float f32x2_t __attribute__((ext_vector_type(2))); typedef __bf16 bf16x2_t __attribute__((ext_vector_type(2)));
__device__ __forceinline__ unsigned cvtpk_s(float lo,float hi){f32x2_t v={lo,hi};bf16x2_t b=__builtin_convertvector(v,bf16x2_t);return __builtin_bit_cast(unsigned,b);}
#define WAIT_BAR(N) asm volatile("s_waitcnt vmcnt(" #N ") lgkmcnt(0)\n\ts_barrier":::"memory")

__device__ __forceinline__ void qkt(f32x16&p0,f32x16&p1,const char*Kslot,const bf16x8*qr,const f32x16&negm,int r32,int hi){
  const char*kb=Kslot+hi*1024+r32*16;
  #pragma unroll
  for(int d0=0;d0<4;++d0){
    const bf16x8 b0=*reinterpret_cast<const bf16x8*>(kb+d0*2048);
    const bf16x8 b1=*reinterpret_cast<const bf16x8*>(kb+d0*2048+512);
    if(d0==0){p0=__builtin_amdgcn_mfma_f32_32x32x16_bf16(b0,qr[0],negm,0,0,0);p1=__builtin_amdgcn_mfma_f32_32x32x16_bf16(b1,qr[0],negm,0,0,0);}
    else{p0=__builtin_amdgcn_mfma_f32_32x32x16_bf16(b0,qr[d0],p0,0,0,0);p1=__builtin_amdgcn_mfma_f32_32x32x16_bf16(b1,qr[d0],p1,0,0,0);}}
}
typedef __attribute__((address_space(3))) const char* lds_cptr;
typedef short v4i16_t __attribute__((ext_vector_type(4)));
__device__ __forceinline__ void kload8(bf16x8*kf,lds_cptr kp){
  kf[0]=*(const __attribute__((address_space(3))) bf16x8*)(kp);      kf[1]=*(const __attribute__((address_space(3))) bf16x8*)(kp+512);
  kf[2]=*(const __attribute__((address_space(3))) bf16x8*)(kp+2048); kf[3]=*(const __attribute__((address_space(3))) bf16x8*)(kp+2560);
  kf[4]=*(const __attribute__((address_space(3))) bf16x8*)(kp+4096); kf[5]=*(const __attribute__((address_space(3))) bf16x8*)(kp+4608);
  kf[6]=*(const __attribute__((address_space(3))) bf16x8*)(kp+6144); kf[7]=*(const __attribute__((address_space(3))) bf16x8*)(kp+6656);
}
__device__ __forceinline__ void kload2(bf16x8*kf,lds_cptr kp,int j){ kf[2*j]=*(const __attribute__((address_space(3))) bf16x8*)(kp+j*2048); kf[2*j+1]=*(const __attribute__((address_space(3))) bf16x8*)(kp+j*2048+512); }
__device__ __forceinline__ s16x4 vtr(lds_cptr p){ return __builtin_bit_cast(s16x4,__builtin_amdgcn_ds_read_tr16_b64_v4i16((__attribute__((address_space(3))) v4i16_t*)p)); }
__device__ __forceinline__ float rowmax(const f32x16&p0,const f32x16&p1){
  float a=max3f(p0[0],p0[1],p1[0]),b=max3f(p0[2],p0[3],p1[1]);a=max3f(a,p1[2],p1[3]);
  #pragma unroll
  for(int r=4;r<16;r+=4){a=max3f(a,p0[r],p0[r+1]);b=max3f(b,p0[r+2],p0[r+3]);a=max3f(a,p1[r],p1[r+1]);b=max3f(b,p1[r+2],p1[r+3]);}
  const float m=max2f(a,b);
  auto rr=__builtin_amdgcn_permlane32_swap(__float_as_uint(m),__float_as_uint(m),false,false);
  return max2f(__uint_as_float(rr[0]),__uint_as_float(rr[1]));
}
__device__ __forceinline__ void pv(f32x16*o,int vb,bf16x8 pa0,bf16x8 pa1,bf16x8 pa2,bf16x8 pa3){
  #pragma unroll
  for(int d0=0;d0<2;++d0){s16x4 lo[4],hi[4];
    #pragma unroll
    for(int ks=0;ks<4;++ks){
      asm volatile("ds_read_b64_tr_b16 %0,%1 offset:%c2":"=&v"(lo[ks]):"v"(vb),"i"(d0*4096+ks*1024):"memory");
      asm volatile("ds_read_b64_tr_b16 %0,%1 offset:%c2":"=&v"(hi[ks]):"v"(vb),"i"(d0*4096+ks*1024+512):"memory");}
    asm volatile("s_waitcnt lgkmcnt(0)":::"memory");SBAR();
    #define PK(k) (bf16x8){lo[k][0],lo[k][1],lo[k][2],lo[k][3],hi[k][0],hi[k][1],hi[k][2],hi[k][3]}
    o[d0]=__builtin_amdgcn_mfma_f32_32x32x16_bf16(pa0,PK(0),o[d0],0,0,0);
    o[d0]=__builtin_amdgcn_mfma_f32_32x32x16_bf16(pa1,PK(1),o[d0],0,0,0);
    o[d0]=__builtin_amdgcn_mfma_f32_32x32x16_bf16(pa2,PK(2),o[d0],0,0,0);
    o[d0]=__builtin_amdgcn_mfma_f32_32x32x16_bf16(pa3,PK(3),o[d0],0,0,0);
    #undef PK
  }
}

#ifndef ATTN_STORE16
#define ATTN_STORE16(p,v) (*(u32x4*)(p)=(v))
#endif
template<int THRL> __device__ __forceinline__ void attn_unit(int b,int h,int qb,const bf16*Q,const bf16*__restrict__ K,const bf16*__restrict__ V,bf16*O,float*ssq,char*shm){
  const int tid=threadIdx.x,lane=tid&63,r32=lane&31,hi=lane>>5; const int wid=__builtin_amdgcn_readfirstlane(tid>>6);
  const long rowbase=(long)b*SEQ; const int q0=qb*QB;
  const bf16*Qw=Q+(rowbase+q0+wid*QBLK)*QP+h*D; const int kvh=h>>2;
  const bf16*Kh=K+rowbase*KP+kvh*D,*Vh=V+rowbase*KP+kvh*D;
  const unsigned lds0=(unsigned)(uintptr_t)shm;
  float*wsf=(float*)(shm+LDS_WS)+wid*64;
  const bf16*ksrc=Kh+(long)lane*KP+wid*8;
  const bf16*vsrc=Vh+(long)(16*(wid&3)+(lane>>2))*KP+(wid>>2)*32+(lane&3)*8;
  const unsigned kdst=lds0+LDS_K+wid*1024, vdst=lds0+LDS_V+wid*1024;
  #define DMA_K(t,slot) glds16(ksrc+(long)(t)*KVBLK*KP,(unsigned)__builtin_amdgcn_readfirstlane(kdst+(slot)))
  #define DMA_V(t,slot) glds16(vsrc+(long)(t)*KVBLK*KP,(unsigned)__builtin_amdgcn_readfirstlane(vdst+(slot)))
  const int vb0=(int)(lds0+LDS_V)+((lane>>4)&1)*32+(lane&3)*8+(4*hi+((lane&15)>>2))*64;
  const char*Kbase=shm+LDS_K; bf16x8 kf[8];
  const lds_cptr shm3=(lds_cptr)shm; const lds_cptr kp0=shm3+LDS_K+hi*1024+r32*16; const lds_cptr vp0=shm3+LDS_V+((lane>>4)&1)*32+(lane&3)*8+(4*hi+((lane&15)>>2))*64;
  const int NT=SEQ/KVBLK;
  DMA_K(0,0);DMA_V(0,0);DMA_K(1,SLOTB);
  bf16x8 qr[4];
  #pragma unroll
  for(int d0=0;d0<4;++d0)qr[d0]=*reinterpret_cast<const bf16x8*>(&Qw[(long)r32*QP+d0*16+hi*8]);
  float mhat=0.f,l_reg=0.f;f32x16 o[2];o[0]=f32x16{};o[1]=f32x16{};f32x16 negm=f32x16{};asm volatile("":"+v"(negm));

  #define CMASK(P0,P1,t) do{}while(0)
  bool resc=false;
  #define START(P0,P1) do{ const float rm=rowmax(P0,P1); resc=false; \
    { const float dl=rm; mhat=fadd_s(mhat,dl); \
      _Pragma("unroll") for(int r=0;r<16;++r){P0[r]=fsub_s(P0[r],dl);P1[r]=fsub_s(P1[r],dl);} \
      _Pragma("unroll") for(int r=0;r<16;++r)negm[r]=-mhat; asm volatile("":"+v"(negm)); } \
    _Pragma("unroll") for(int r=0;r<16;++r)P0[r]=__builtin_amdgcn_exp2f(P0[r]); }while(0)
  #define RESC() do{ if(resc){ asm volatile("s_waitcnt lgkmcnt(0)":::"memory"); \
      _Pragma("unroll") for(int d_=0;d_<2;++d_) _Pragma("unroll") for(int r=0;r<16;++r)o[d_][r]*=wsf[crow(r,hi)]; } }while(0)
  f32x16 pA0,pA1,pB0,pB1;
  int sl_prev=0,sl_cur=0,sl_next=SLOTB;
  #define ROT() do{sl_prev=sl_cur;sl_cur=sl_next;sl_next=(sl_next==(NSLOT-1)*SLOTB)?0:sl_next+SLOTB;}while(0)
  DMA_K(2,2*SLOTB);
  WAIT_BAR(3);
  qkt(pA0,pA1,Kbase,qr,negm,r32,hi);asm volatile("s_nop 15\n\ts_nop 7":"+v"(pA0),"+v"(pA1));CMASK(pA0,pA1,0);
  START(pA0,pA1);
  _Pragma("unroll") for(int r=0;r<16;++r)pA1[r]=__builtin_amdgcn_exp2f(pA1[r]);
  WAIT_BAR(0);
  DMA_K(3,0);DMA_V(1,SLOTB);
  ROT();
  kload8(kf,kp0+sl_cur);
  WAIT_BAR(2);
  s16x4 vlo[8],vhi[8]; u32x4 pw0,pw1,pw2,pw3;
  #define PKW(P,B) cvtpk_s(P[B],P[B+1])
  #define PAF(k) __builtin_bit_cast(bf16x8,pw##k)
  #define VFR(i) (bf16x8){vlo[i][0],vlo[i][1],vlo[i][2],vlo[i][3],vhi[i][0],vhi[i][1],vhi[i][2],vhi[i][3]}
  #define PIN(x) asm volatile("":"+v"(x))
  #define MX3(a,b,c) __builtin_fmaxf(__builtin_fmaxf((a),(b)),(c))
  #define GAPA(MF,A0,A1,A2,A3,W0,W1,PW) do{ MF; sacc+=A0; sacc+=A1; sacc+=A2; sacc+=A3; PIN(sacc); W0; W1; PIN(PW); SBAR(); }while(0)
  #define EX(v) __builtin_amdgcn_exp2f(v)
  #define GAPB(MF,X,B) do{ MF; X[B]=EX(X[B]); X[B+1]=EX(X[B+1]); X[B+2]=EX(X[B+2]); X[B+3]=EX(X[B+3]); PIN(X); SBAR(); }while(0)
  #define VRD(i) do{ vlo[i]=vtr(vp_+(((i)>>2)*4096+((i)&3)*1024)); vhi[i]=vtr(vp_+(((i)>>2)*4096+((i)&3)*1024+512)); }while(0)
  #define KRD(G,j) do{ if(G){ kload2(kf,kp0+sl_next,j); SBAR(); } }while(0)
  #define STEP(C0,C1,P0,P1,t,GK,GV,GL) do{ SBAR(); \
    const lds_cptr vp_=vp0+sl_prev; \
    VRD(0); SBAR(); float sacc=(P0[0]+P0[1]); \
    GAPA(C0=__builtin_amdgcn_mfma_f32_32x32x16_bf16(kf[0],qr[0],negm,0,0,0), P0[2],P0[3],P0[4],P0[5],     pw0[0]=PKW(P0,0), pw0[1]=PKW(P0,2), pw0); \
    VRD(4); SBAR(); GAPA(C1=__builtin_amdgcn_mfma_f32_32x32x16_bf16(kf[1],qr[0],negm,0,0,0), P0[6],P0[7],P0[8],P0[9],     pw0[2]=PKW(P0,4), pw0[3]=PKW(P0,6), pw0); \
    VRD(1); SBAR(); GAPA(C0=__builtin_amdgcn_mfma_f32_32x32x16_bf16(kf[2],qr[1],C0,0,0,0),   P0[10],P0[11],P0[12],P0[13], pw1[0]=PKW(P0,8), pw1[1]=PKW(P0,10), pw1); \
    VRD(5); SBAR(); GAPA(C1=__builtin_amdgcn_mfma_f32_32x32x16_bf16(kf[3],qr[1],C1,0,0,0),   P0[14],P0[15],P1[0],P1[1],   pw1[2]=PKW(P0,12),pw1[3]=PKW(P0,14), pw1); \
    VRD(2); SBAR(); GAPA(C0=__builtin_amdgcn_mfma_f32_32x32x16_bf16(kf[4],qr[2],C0,0,0,0),   P1[2],P1[3],P1[4],P1[5],     pw2[0]=PKW(P1,0), pw2[1]=PKW(P1,2), pw2); \
    VRD(6); SBAR(); GAPA(C1=__builtin_amdgcn_mfma_f32_32x32x16_bf16(kf[5],qr[2],C1,0,0,0),   P1[6],P1[7],P1[8],P1[9],     pw2[2]=PKW(P1,4), pw2[3]=PKW(P1,6), pw2); \
    VRD(3); SBAR(); GAPA(C0=__builtin_amdgcn_mfma_f32_32x32x16_bf16(kf[6],qr[3],C0,0,0,0),   P1[10],P1[11],P1[12],P1[13], pw3[0]=PKW(P1,8), pw3[1]=PKW(P1,10), pw3); \
    VRD(7); SBAR(); GAPA(C1=__builtin_amdgcn_mfma_f32_32x32x16_bf16(kf[7],qr[3],C1,0,0,0),   P1[14],P1[15],0.f,0.f,       pw3[2]=PKW(P1,12),pw3[3]=PKW(P1,14), pw3); \
    l_reg+=sacc; \
    if(GK){DMA_K((t)+3,sl_cur);} if(GV){DMA_V((t)+1,sl_next);} \
    CMASK(C0,C1,t); \
    { float a=MX3(C0[0],C0[1],C1[0]),b=MX3(C0[2],C0[3],C1[1]); a=MX3(a,C1[2],C1[3]); \
      _Pragma("unroll") for(int r=4;r<16;r+=4){a=MX3(a,C0[r],C0[r+1]);b=MX3(b,C0[r+2],C0[r+3]);a=MX3(a,C1[r],C1[r+1]);b=MX3(b,C1[r+2],C1[r+3]);} \
      float rm=__builtin_fmaxf(a,b); { auto rr=__builtin_amdgcn_permlane32_swap(__float_as_uint(rm),__float_as_uint(rm),false,false); rm=__builtin_fmaxf(__uint_as_float(rr[0]),__uint_as_float(rr[1])); } \
      resc=false; \
      if(__builtin_expect(__any(rm>(float)THRL),0)){ const float dl=__builtin_fmaxf(rm,0.f); mhat+=dl; \
        _Pragma("unroll") for(int r=0;r<16;++r){C0[r]-=dl;C1[r]-=dl;} \
        _Pragma("unroll") for(int r=0;r<16;++r)negm[r]=-mhat; asm volatile("":"+v"(negm)); \
        const float f=__builtin_amdgcn_exp2f(-dl); l_reg*=f; if(hi==0)wsf[r32]=f; resc=true; } } \
    SBAR(); \
    GAPB(o[0]=__builtin_amdgcn_mfma_f32_32x32x16_bf16(PAF(0),VFR(0),o[0],0,0,0), C0,0); \
    GAPB(o[1]=__builtin_amdgcn_mfma_f32_32x32x16_bf16(PAF(0),VFR(4),o[1],0,0,0), C0,4); \
    KRD(GL,0); GAPB(o[0]=__builtin_amdgcn_mfma_f32_32x32x16_bf16(PAF(1),VFR(1),o[0],0,0,0), C0,8); \
    KRD(GL,1); GAPB(o[1]=__builtin_amdgcn_mfma_f32_32x32x16_bf16(PAF(1),VFR(5),o[1],0,0,0), C0,12); \
    KRD(GL,2); GAPB(o[0]=__builtin_amdgcn_mfma_f32_32x32x16_bf16(PAF(2),VFR(2),o[0],0,0,0), C1,0); \
    KRD(GL,3); GAPB(o[1]=__builtin_amdgcn_mfma_f32_32x32x16_bf16(PAF(2),VFR(6),o[1],0,0,0), C1,4); \
    GAPB(o[0]=__builtin_amdgcn_mfma_f32_32x32x16_bf16(PAF(3),VFR(3),o[0],0,0,0), C1,8); \
    GAPB(o[1]=__builtin_amdgcn_mfma_f32_32x32x16_bf16(PAF(3),VFR(7),o[1],0,0,0), C1,12); \
    }while(0)
  int t=1;
  #undef CMASK
  #define CMASK(P0,P1,t) do{}while(0)
  for(;t+5<NT;t+=2){
    STEP(pB0,pB1,pA0,pA1,t,true,true,true);     WAIT_BAR(2); RESC(); ROT();
    STEP(pA0,pA1,pB0,pB1,t+1,true,true,true);   WAIT_BAR(2); RESC(); ROT();
  }
  #undef CMASK
  #define CMASK(P0,P1,t) do{}while(0)
  #define ENDW(tt) do{ if((tt)+3<NT){WAIT_BAR(2);} else if((tt)+2<NT){WAIT_BAR(1);} else {WAIT_BAR(0);} }while(0)
  for(;t+1<NT;t+=2){
    STEP(pB0,pB1,pA0,pA1,t,(t+3<NT),(t+1<NT),(t+1<NT));       ENDW(t);   RESC(); ROT();
    STEP(pA0,pA1,pB0,pB1,t+1,(t+4<NT),(t+2<NT),(t+2<NT));     ENDW(t+1); RESC(); ROT();
  }
  STEP(pB0,pB1,pA0,pA1,NT-1,false,false,false); RESC();
  { float sacc=pB0[0]+pB0[1]; _Pragma("unroll") for(int r=2;r<16;++r)sacc+=pB0[r]; _Pragma("unroll") for(int r=0;r<16;++r)sacc+=pB1[r]; l_reg+=sacc;
    pw0=(u32x4){PKW(pB0,0),PKW(pB0,2),PKW(pB0,4),PKW(pB0,6)};pw1=(u32x4){PKW(pB0,8),PKW(pB0,10),PKW(pB0,12),PKW(pB0,14)};pw2=(u32x4){PKW(pB1,0),PKW(pB1,2),PKW(pB1,4),PKW(pB1,6)};pw3=(u32x4){PKW(pB1,8),PKW(pB1,10),PKW(pB1,12),PKW(pB1,14)};
    SBAR(); pv(o,vb0+sl_cur,PAF(0),PAF(1),PAF(2),PAF(3)); }
  #undef PKW
  #undef PAF
  #undef VFR
  #undef PIN
  #undef MX3
  #undef GAPA
  #undef GAPB
  #undef EX
  #undef VRD
  #undef KRD
  #undef STEP
  #undef ENDW
  {auto rr=__builtin_amdgcn_permlane32_swap(__float_as_uint(l_reg),__float_as_uint(l_reg),false,false);l_reg=__uint_as_float(rr[0])+__uint_as_float(rr[1]);}
  if(hi==0)wsf[32+r32]=l_reg;asm volatile("s_waitcnt lgkmcnt(0)":::"memory");
  float rli[16];
  #pragma unroll
  for(int r=0;r<16;++r)rli[r]=__builtin_amdgcn_rcpf(wsf[32+crow(r,hi)]);
  bf16*Ow=O+(rowbase+q0+wid*QBLK)*OP+h*D; float*ssw=ssq+rowbase+q0+wid*QBLK;
  { bf16*stg=(bf16*)(shm+LDS_OST)+wid*2048;
    #pragma unroll
    for(int r=0;r<16;++r){const int orow=crow(r,hi);
      #pragma unroll
      for(int d0=0;d0<2;++d0)stg[orow*64+d0*32+r32]=__float2bfloat16(o[d0][r]*rli[r]);}
    asm volatile("s_waitcnt lgkmcnt(0)":::"memory");
    #pragma unroll
    for(int i=0;i<4;++i){const int row=i*8+(lane>>3),ch=lane&7; const u32x4 v=*(const u32x4*)(stg+row*64+ch*8); ATTN_STORE16(Ow+(long)row*OP+ch*8,v);
      float sq=0.f; _Pragma("unroll") for(int e=0;e<4;++e){const float a=__uint_as_float(v[e]<<16),c=__uint_as_float(v[e]&0xffff0000u); sq+=a*a+c*c;}
      sq+=__shfl_xor(sq,1); sq+=__shfl_xor(sq,2); sq+=__shfl_xor(sq,4); if(ch==0)atomicAdd(ssw+row,sq);} }
  asm volatile("s_waitcnt lgkmcnt(0)\n\ts_barrier":::"memory");
  #undef DMA_K
  #undef DMA_V
  #undef CMASK
  #undef START
  #undef RESC
  #undef ROT
}
constexpr int ATTN_LDS_BYTES=LDS_BYTES;
struct AttnTensors { const bf16* Q; const bf16* K; const bf16* V; bf16* O; float* ssq; };
struct AttnUnit { int bh; int qb; };
struct StaticOrder {
  int vcu, G;
  __device__ __forceinline__ explicit StaticOrder(int grid,int block):vcu((grid%8==0)?(block%8)*(grid/8)+block/8:block),G(grid){}
  __device__ __forceinline__ bool next(int i,AttnUnit&u)const{ const int n=vcu+i*G; if(n>=BATCH*NHEAD*NQB)return false; u.bh=n>>5; u.qb=n&31; return true; }
  __device__ __forceinline__ void a_ready(const AttnUnit&)const{}
  __device__ __forceinline__ void done(const AttnUnit&)const{}
};
template<class Sched,int THRL=8> __device__ __forceinline__ void attn_phase(char*lds,const AttnTensors&T,const Sched&S){
  AttnUnit u;
  for(int i=0;S.next(i,u);++i){ S.a_ready(u); attn_unit<THRL>(u.bh/NHEAD,u.bh%NHEAD,u.qb,T.Q,T.K,T.V,T.O,T.ssq,lds); S.done(u); }
}
#undef SBAR
#undef WAIT_BAR
}
__global__ void __launch_bounds__(NTHREADS, 2) fwd_kernel(Params p) {
    extern __shared__ __attribute__((aligned(16))) unsigned char lds_raw[];
    LAS unsigned char* lds = (LAS unsigned char*)lds_raw;
    cg::grid_group grid = cg::this_grid();
    const int bid = blockIdx.x, nb = gridDim.x, tid = threadIdx.x, lane = tid & 63, wave = tid >> 6;
    const int lo = p.ph_lo, hi = p.ph_hi;
#define IN(k) (lo <= (k) && (k) < hi)
#define SEAM(k) do { if (IN(k) && IN((k) + 1)) grid.sync(); } while (0)
    unsigned char* ws = p.ws;
    float* ssatt = (float*)(ws + WS_CTL + CTL_SSATT); float* ss2 = (float*)(ws + WS_CTL + CTL_SS2); float* ss3 = (float*)(ws + WS_CTL + CTL_SS3); const float* LB = (const float*)(ws + WS_CTL + CTL_LB);

    if (IN(0)) { p0_prologue(p, lds, bid, nb); } SEAM(0);
    if (IN(1)) { pg8::PgEpiIn E{(bf16_t*)(ws + WS_QH), (float*)(ws + WS_ZF), (bf16_t*)(ws + WS_IV), (bf16_t*)(ws + WS_GH), (float*)(ws + WS_AQKV), LB};
        pg8::Gemm g{(const bf16_t*)(ws + WS_XN), (const bf16_t*)(ws + WS_WIN), M, DIN, D}; pg8::StaticOrder S; S.init(M, DIN, nb, bid);
        pg8::gemm_phase<pg8::PgEpiIn, pg8::StaticOrder, true, true>(lds, g, S, E); } SEAM(1);
    if (IN(2)) { p2_qkconvert(p, bid, nb);
        for (int u = bid; u < 512; u += nb) { const int dir = u >> 8, b = (u >> 7) & 1, h = (u >> 5) & 3, sc = u & 31; if (dir == 0) hg::pass1_unit<0>(p, lds, b, h, sc); else hg::pass1_unit<1>(p, lds, b, h, sc); }
    } SEAM(2);
    if (IN(3)) { hg::scan_phase(p, bid, nb); } SEAM(3);
    if (IN(4)) {
        for (int u = bid; u < 256; u += nb) hg::pass2_unit(p, lds, u >> 7, (u >> 5) & 3, u & 31);
        { const attn_body::AttnTensors AT{(const attn_body::bf16*)(ws + WS_QA), (const attn_body::bf16*)(ws + WS_KA), (const attn_body::bf16*)(ws + WS_VA), (attn_body::bf16*)(ws + WS_MIX), ssatt};
          const attn_body::StaticOrder SO(nb, bid);
          attn_body::attn_phase<attn_body::StaticOrder>((char*)lds_raw, AT, SO); }
    } SEAM(4);
    if (IN(5)) { pg8::PgEpiOut E{p.x, p.out, (bf16_t*)(ws + WS_XB), ss2, ssatt};
        pg8::Gemm g{(const bf16_t*)(ws + WS_MIX), (const bf16_t*)(ws + WS_WOUT), M, D, D}; pg8::StaticOrder S; S.init(M, D, nb, bid);
        pg8::gemm_phase<pg8::PgEpiOut, pg8::StaticOrder, true, true>(lds, g, S, E); } SEAM(5);
    if (IN(6)) { pg8::PgEpiGU E{(bf16_t*)(ws + WS_H), ss2};
        pg8::Gemm g{(const bf16_t*)(ws + WS_XB), (const bf16_t*)(ws + WS_WGU), M, 2 * DFF, D}; pg8::StaticOrder S; S.init(M, 2 * DFF, nb, bid);
        pg8::gemm_phase<pg8::PgEpiGU, pg8::StaticOrder, true, true>(lds, g, S, E); } SEAM(6);
    if (IN(7)) { pg8::PgEpiDown E{p.out, ss3};
        pg8::Gemm g{(const bf16_t*)(ws + WS_H), (const bf16_t*)(ws + WS_WDN), M, D, DFF}; pg8::StaticOrder S; S.init(M, D, nb, bid);
        pg8::gemm_phase<pg8::PgEpiDown, pg8::StaticOrder, true, true>(lds, g, S, E); } SEAM(7);
    if (IN(8)) {
        const int gw = bid * NWAVES + wave, NGW = nb * NWAVES;
        for (int m = gw; m < M; m += NGW) { f32x4* xr = (f32x4*)(p.out + (size_t)m * D) + lane; const f32x4* wr = (const f32x4*)p.final_norm_w + lane;
            const float rstd = 1.f / sqrtf(ss3[m] * (1.f / D) + EPS);
#pragma unroll
            for (int j = 0; j < 4; ++j) { f32x4 v = xr[64 * j]; const f32x4 w = wr[64 * j]; v.x *= rstd * w.x; v.y *= rstd * w.y; v.z *= rstd * w.z; v.w *= rstd * w.w; xr[64 * j] = v; } }
    }
#undef IN
#undef SEAM
}

extern "C" void kernel_launch(void* const* d_in, const int* in_sizes, int n_in, void* d_out, int out_size, void* d_ws, size_t ws_size, hipStream_t stream) {
    static int grid = 0;
    if (grid == 0) {
        if (n_in != 13 || in_sizes[0] != M * D || out_size != M * D || ws_size < WS_END) { fprintf(stderr, "kernel_launch: unexpected shapes (n_in %d, in0 %d, out %d, ws %zu)\n", n_in, n_in > 0 ? in_sizes[0] : -1, out_size, ws_size); grid = -1; return; }
        int dev = 0, cus = 0, per_cu = 0;
        hipGetDevice(&dev); hipDeviceGetAttribute(&cus, hipDeviceAttributeMultiprocessorCount, dev);
        if (hipFuncSetAttribute((const void*)fwd_kernel, hipFuncAttributeMaxDynamicSharedMemorySize, LDS_BYTES) != hipSuccess) { fprintf(stderr, "kernel_launch: hipFuncSetAttribute failed\n"); grid = -1; return; }
        if (hipOccupancyMaxActiveBlocksPerMultiprocessor(&per_cu, (const void*)fwd_kernel, NTHREADS, LDS_BYTES) != hipSuccess || per_cu < 1) { fprintf(stderr, "kernel_launch: occupancy query says %d\n", per_cu); per_cu = 1; }
        (void)hipGetLastError();
        grid = cus;
    }
    if (grid < 0) return;
    hipMemsetAsync((char*)d_ws + WS_CTL, 0, CTL_ZERO_BYTES, stream);
    Params p{};
    p.x = (const float*)d_in[0]; p.norm1_w = (const float*)d_in[1]; p.w_in = (const float*)d_in[2]; p.lb_logits = (const float*)d_in[3]; p.hg_norm_w = (const float*)d_in[4];
    p.q_norm_w = (const float*)d_in[5]; p.k_norm_w = (const float*)d_in[6]; p.att_norm_w = (const float*)d_in[7]; p.w_out = (const float*)d_in[8]; p.norm2_w = (const float*)d_in[9];
    p.w_gate_up = (const float*)d_in[10]; p.w_down = (const float*)d_in[11]; p.final_norm_w = (const float*)d_in[12];
    p.out = (float*)d_out; p.ws = (unsigned char*)d_ws;
#if MK_N_LAUNCHES == 1
    p.ph_lo = 0; p.ph_hi = NPH;
    void* args[] = {&p};
    hipError_t e = hipLaunchCooperativeKernel((const void*)fwd_kernel, dim3(grid), dim3(NTHREADS), args, LDS_BYTES, stream);
    if (e != hipSuccess) fprintf(stderr, "cooperative launch failed: %s (grid %d)\n", hipGetErrorString(e), grid);
#else
    for (int ph = 0; ph < NPH; ++ph) { p.ph_lo = ph; p.ph_hi = ph + 1; hipLaunchKernelGGL(fwd_kernel, dim3(grid), dim3(NTHREADS), LDS_BYTES, stream, p); }
#endif
}
```

```cpp
#include <hip/hip_runtime.h>
#include <hip/hip_cooperative_groups.h>
#include <cstdio>
#include <cstdint>
namespace cg = cooperative_groups;

#ifndef PROBE_DUP
#define PROBE_DUP 0
#endif
#ifndef MK_N_LAUNCHES
#define MK_N_LAUNCHES 1
#endif

#define LAS __attribute__((address_space(3)))
typedef unsigned short bf16_t;
typedef short bf16x8 __attribute__((ext_vector_type(8)));
typedef short bf16x4 __attribute__((ext_vector_type(4)));
typedef float f32x2 __attribute__((ext_vector_type(2)));
typedef float f32x4 __attribute__((ext_vector_type(4)));
typedef float f32x16 __attribute__((ext_vector_type(16)));
typedef unsigned u32x2 __attribute__((ext_vector_type(2)));
typedef unsigned u32x4 __attribute__((ext_vector_type(4)));

constexpr int BATCH = 2, SEQ = 8192, M = BATCH * SEQ, D = 1024, DIN = 3328, DFF = 2816;
constexpr float EPS = 1e-6f;
constexpr float C2 = 0.125f * 1.4426950408889634f;
constexpr int NPH = 9;
constexpr int NTHREADS = 512, NWAVES = 8;
constexpr int LDS_BYTES = 147456;

constexpr size_t MiB = 1u << 20;
constexpr size_t WS_CTL = 0, CTL_ZERO_BYTES = 1 * MiB;
constexpr size_t CTL_SSATT = 64 * 1024, CTL_SS2 = 128 * 1024, CTL_SS3 = 192 * 1024, CTL_LB = 256 * 1024;
constexpr size_t WS_WIN = 1 * MiB, WS_WOUT = 8 * MiB, WS_WGU = 10 * MiB, WS_WDN = 21 * MiB;
constexpr size_t WS_XN = 27 * MiB;
constexpr size_t WS_QH = 59 * MiB;
constexpr size_t WS_IV = 75 * MiB;
constexpr size_t WS_GH = 91 * MiB;
constexpr size_t WS_ZF = 107 * MiB;
constexpr size_t WS_AQKV = 171 * MiB;
constexpr size_t WS_MIX = 171 * MiB;
constexpr size_t WS_QA = 219 * MiB;
constexpr size_t WS_KA = 235 * MiB;
constexpr size_t WS_VA = 239 * MiB;
constexpr size_t WS_VT = 243 * MiB;
constexpr size_t WS_SEND = 27 * MiB;
constexpr size_t WS_DTOT = 247 * MiB;
constexpr size_t WS_OFW = 203 * MiB;
constexpr size_t WS_XB = 59 * MiB;
constexpr size_t WS_H = 91 * MiB;
constexpr size_t WS_END = 256 * MiB;
static_assert(WS_WDN + (size_t)D * DFF * 2 <= WS_XN && WS_H + (size_t)M * DFF * 2 <= WS_QA && WS_VT + (size_t)4 * 64 * SEQ * 2 <= WS_END, "ws map");

struct Params {
    const float* x; const float* norm1_w; const float* w_in; const float* lb_logits; const float* hg_norm_w; const float* q_norm_w; const float* k_norm_w;
    const float* att_norm_w; const float* w_out; const float* norm2_w; const float* w_gate_up; const float* w_down; const float* final_norm_w;
    float* out; unsigned char* ws; int ph_lo, ph_hi, use_cg, pad;
};

__device__ __forceinline__ unsigned f2bf(float f) { unsigned u = __builtin_bit_cast(unsigned, f); return (u + 0x7fffu + ((u >> 16) & 1u)) >> 16; }
__device__ __forceinline__ unsigned pk2(float lo, float hi) { return f2bf(lo) | (f2bf(hi) << 16); }
__device__ __forceinline__ float bf2f(bf16_t b) { return __builtin_bit_cast(float, (unsigned)b << 16); }
__device__ __forceinline__ float silu_f(float v) { return v * __builtin_amdgcn_rcpf(1.f + __builtin_amdgcn_exp2f(-1.4426950408889634f * v)); }
__device__ __forceinline__ float sigmoid_f(float v) { return __builtin_amdgcn_rcpf(1.f + __builtin_amdgcn_exp2f(-1.4426950408889634f * v)); }
__device__ __forceinline__ int crow(int r, int hi) { return (r & 3) + 8 * (r >> 2) + 4 * hi; }
__device__ __forceinline__ float wave_sum(float v) {
#pragma unroll
    for (int o = 1; o < 64; o <<= 1) v += __shfl_xor(v, o);
    return v;
}

namespace pg8 {
#define PG8_LAS __attribute__((address_space(3)))
typedef unsigned short bf16_t;
typedef short bf16x8 __attribute__((ext_vector_type(8)));
typedef float f32x4 __attribute__((ext_vector_type(4)));
typedef unsigned u32x4 __attribute__((ext_vector_type(4)));
constexpr int BM = 256, BK = 64, HALF = 128, HTB = HALF * BK * 2  , STAGE_BYTES = 8 * HTB, NXCD = 8, WGM = 8;

__host__ __device__ __forceinline__ int lds_byte(int r, int c) { const int st = (r >> 4) * 2 + (c >> 5), rr = r & 15, cc = c & 31, ob = rr * 64 + cc * 2; return st * 1024 + (ob ^ (((ob >> 9) & 1) << 5)); }
__host__ __device__ __forceinline__ void stage_rc(int b, int& R, int& C) { const int st = b / 1024, sb = b % 1024, swz = sb ^ (((sb >> 9) & 1) << 5); R = (st >> 1) * 16 + swz / 64; C = (st & 1) * 32 + (swz % 64) / 2; }
__host__ __device__ __forceinline__ int perm32(int rho) { const int n = rho >> 4, i = rho & 15; return 8 * (i >> 2) + 4 * n + (i & 3); }

struct Unit { int pm, pn; };
struct Gemm { const bf16_t* A; const bf16_t* Bt; int M, N, K; };

struct StaticOrder {
    int nM, nN, nwg, G, c;
    __host__ __device__ void init(int M, int N, int G_, int c_) { nM = M / BM; nN = N / BM; nwg = nM * nN; G = G_; c = c_; }
    __host__ __device__ bool next(int i, Unit& u) const {
        const long L = (long)i * G + c; if (L >= nwg) return false;
        int wgid = (int)L; { const int q = nwg / NXCD, r = nwg % NXCD, xcd = wgid % NXCD, off = wgid / NXCD; wgid = (xcd < r ? xcd * (q + 1) : r * (q + 1) + (xcd - r) * q) + off; }
        const int nig = WGM * nN, gid = wgid / nig, fm = gid * WGM, gsz = (nM - fm) < WGM ? (nM - fm) : WGM;
        u.pm = fm + ((wgid % nig) % gsz); u.pn = (wgid % nig) / gsz; return true;
    }
    __device__ __forceinline__ void a_ready(const Unit&) const {}
    __device__ __forceinline__ void done(const Unit&) const {}
};

__device__ __forceinline__ unsigned cvt_pk_bf16(float lo, float hi) { unsigned r; asm volatile("v_cvt_pk_bf16_f32 %0, %1, %2" : "=v"(r) : "v"(lo), "v"(hi)); return r; }
typedef float f32x2 __attribute__((ext_vector_type(2)));
__device__ __forceinline__ f32x4 silu4(f32x4 v) { f32x4 o; o.x = silu_f(v.x); o.y = silu_f(v.y); o.z = silu_f(v.z); o.w = silu_f(v.w); return o; }
struct PgEpiIn {
    static constexpr bool PERM = true, AFTER_DRAIN = false, MID = false; static constexpr int MID_T = 0;
    bf16_t* QH; float* ZF; bf16_t* IV; bf16_t* GH; float* AQKV; const float* LB;
    __device__ __forceinline__ void mid(f32x4 (&)[2][2][4][2], const Unit&, int, int) const {}
    __device__ __forceinline__ void operator()(const f32x4 (&acc)[2][2][4][2], const Unit& u, int wr, int wc, int fr, int fq) const {
        const int row0 = u.pm * BM + wr * 64 + fr, pn = u.pn, cw = wc * 32 + 8 * fq;
        if (pn < 2 || (pn >= 6 && pn < 10)) {
            bf16_t* base; int colt; bool act;
            if (pn < 2) { base = QH; colt = pn * 256; act = true; } else if (pn < 8) { base = IV; colt = (pn - 6) * 256; act = false; } else { base = GH; colt = (pn - 8) * 256; act = true; }
#pragma unroll
            for (int ai = 0; ai < 2; ++ai)
#pragma unroll
                for (int m = 0; m < 4; ++m) { bf16_t* rowp = base + (size_t)(row0 + ai * HALF + m * 16) * 512 + colt + cw;
#pragma unroll
                    for (int bj = 0; bj < 2; ++bj) { f32x4 v0 = acc[ai][bj][m][0], v1 = acc[ai][bj][m][1]; if (act) { v0 = silu4(v0); v1 = silu4(v1); }
                        u32x4 w; w.x = cvt_pk_bf16(v0[0], v0[1]); w.y = cvt_pk_bf16(v0[2], v0[3]); w.z = cvt_pk_bf16(v1[0], v1[1]); w.w = cvt_pk_bf16(v1[2], v1[3]);
                        *(u32x4*)(rowp + bj * HALF) = w; } }
        } else if (pn < 6) {
            const int colt = (pn - 2) * 256; f32x4 lb[2][2];
#pragma unroll
            for (int bj = 0; bj < 2; ++bj)
#pragma unroll
                for (int n = 0; n < 2; ++n) lb[bj][n] = *(const f32x4*)(LB + colt + bj * HALF + cw + 4 * n);
#pragma unroll
            for (int ai = 0; ai < 2; ++ai)
#pragma unroll
                for (int m = 0; m < 4; ++m) { float* rowp = ZF + (size_t)(row0 + ai * HALF + m * 16) * 1024 + colt + cw;
#pragma unroll
                    for (int bj = 0; bj < 2; ++bj)
#pragma unroll
                        for (int n = 0; n < 2; ++n) { const f32x4 v = acc[ai][bj][m][n], l = lb[bj][n]; f32x4 f;
                            f.x = l.x + (1.f - l.x) * sigmoid_f(v.x); f.y = l.y + (1.f - l.y) * sigmoid_f(v.y); f.z = l.z + (1.f - l.z) * sigmoid_f(v.z); f.w = l.w + (1.f - l.w) * sigmoid_f(v.w);
                            *(f32x4*)(rowp + bj * HALF + 4 * n) = f; } }
        } else {
            const int colt = (pn - 10) * 256;
#pragma unroll
            for (int ai = 0; ai < 2; ++ai)
#pragma unroll
                for (int m = 0; m < 4; ++m) { float* rowp = AQKV + (size_t)(row0 + ai * HALF + m * 16) * 768 + colt + cw;
#pragma unroll
                    for (int bj = 0; bj < 2; ++bj)
#pragma unroll
                        for (int n = 0; n < 2; ++n) *(f32x4*)(rowp + bj * HALF + 4 * n) = acc[ai][bj][m][n]; }
        }
    }
};
struct PgEpiOut {
    static constexpr bool PERM = true, AFTER_DRAIN = false, MID = true; static constexpr int MID_T = 8;
    const float* x; float* out; bf16_t* XB; float* ss2; const float* ssatt;
    __device__ __forceinline__ void mid(f32x4 (&acc)[2][2][4][2], const Unit& u, int wr, int fr) const {
#pragma unroll
        for (int ai = 0; ai < 2; ++ai)
#pragma unroll
            for (int m = 0; m < 4; ++m) { const float s = 1.f / sqrtf(ssatt[u.pm * BM + ai * HALF + wr * 64 + m * 16 + fr] * (1.f / 512.f) + EPS);
#pragma unroll
                for (int bj = 0; bj < 2; ++bj)
#pragma unroll
                    for (int n = 0; n < 2; ++n) acc[ai][bj][m][n] *= s; }
    }
    __device__ __forceinline__ void operator()(const f32x4 (&acc)[2][2][4][2], const Unit& u, int wr, int wc, int fr, int fq) const {
#pragma unroll
        for (int ai = 0; ai < 2; ++ai)
#pragma unroll
            for (int m = 0; m < 4; ++m) { const int row = u.pm * BM + ai * HALF + wr * 64 + m * 16 + fr; float q = 0.f;
#pragma unroll
                for (int bj = 0; bj < 2; ++bj) { const size_t idx = (size_t)row * D + u.pn * BM + bj * HALF + wc * 32 + 8 * fq;
                    const f32x4 v0 = *(const f32x4*)(x + idx) + acc[ai][bj][m][0], v1 = *(const f32x4*)(x + idx + 4) + acc[ai][bj][m][1];
                    *(f32x4*)(out + idx) = v0; *(f32x4*)(out + idx + 4) = v1;
                    u32x4 w; w.x = cvt_pk_bf16(v0[0], v0[1]); w.y = cvt_pk_bf16(v0[2], v0[3]); w.z = cvt_pk_bf16(v1[0], v1[1]); w.w = cvt_pk_bf16(v1[2], v1[3]);
                    *(u32x4*)(XB + idx) = w;
                    q += (v0[0] * v0[0] + v0[1] * v0[1]) + (v0[2] * v0[2] + v0[3] * v0[3]) + (v1[0] * v1[0] + v1[1] * v1[1]) + (v1[2] * v1[2] + v1[3] * v1[3]); }
                q += __shfl_xor(q, 16); q += __shfl_xor(q, 32);
                if (fq == 0) atomicAdd(ss2 + row, q); }
    }
};
struct PgEpiGU {
    static constexpr bool PERM = true, AFTER_DRAIN = false, MID = false; static constexpr int MID_T = 0;
    bf16_t* H; const float* ss2;
    __device__ __forceinline__ void mid(f32x4 (&)[2][2][4][2], const Unit&, int, int) const {}
    __device__ __forceinline__ void operator()(const f32x4 (&acc)[2][2][4][2], const Unit& u, int wr, int wc, int fr, int fq) const {
#pragma unroll
        for (int ai = 0; ai < 2; ++ai)
#pragma unroll
            for (int m = 0; m < 4; ++m) { const int row = u.pm * BM + ai * HALF + wr * 64 + m * 16 + fr; const float s = 1.f / sqrtf(ss2[row] * (1.f / D) + EPS);
                const f32x4 a0 = silu4(acc[ai][0][m][0] * s) * (acc[ai][1][m][0] * s), a1 = silu4(acc[ai][0][m][1] * s) * (acc[ai][1][m][1] * s);
                u32x4 w; w.x = cvt_pk_bf16(a0[0], a0[1]); w.y = cvt_pk_bf16(a0[2], a0[3]); w.z = cvt_pk_bf16(a1[0], a1[1]); w.w = cvt_pk_bf16(a1[2], a1[3]);
                *(u32x4*)(H + (size_t)row * DFF + 128 * u.pn + wc * 32 + 8 * fq) = w; }
    }
};
struct PgEpiDown {
    static constexpr bool PERM = true, AFTER_DRAIN = false, MID = false; static constexpr int MID_T = 0;
    float* out; float* ss3;
    __device__ __forceinline__ void mid(f32x4 (&)[2][2][4][2], const Unit&, int, int) const {}
    __device__ __forceinline__ void operator()(const f32x4 (&acc)[2][2][4][2], const Unit& u, int wr, int wc, int fr, int fq) const {
#pragma unroll
        for (int ai = 0; ai < 2; ++ai)
#pragma unroll
            for (int m = 0; m < 4; ++m) { const int row = u.pm * BM + ai * HALF + wr * 64 + m * 16 + fr; float q = 0.f;
#pragma unroll
                for (int bj = 0; bj < 2; ++bj) { const size_t idx = (size_t)row * D + u.pn * BM + bj * HALF + wc * 32 + 8 * fq;
                    const f32x4 v0 = *(const f32x4*)(out + idx) + acc[ai][bj][m][0], v1 = *(const f32x4*)(out + idx + 4) + acc[ai][bj][m][1];
                    *(f32x4*)(out + idx) = v0; *(f32x4*)(out + idx + 4) = v1;
                    q += (v0[0] * v0[0] + v0[1] * v0[1]) + (v0[2] * v0[2] + v0[3] * v0[3]) + (v1[0] * v1[0] + v1[1] * v1[1]) + (v1[2] * v1[2] + v1[3] * v1[3]); }
                q += __shfl_xor(q, 16); q += __shfl_xor(q, 32);
                if (fq == 0) atomicAdd(ss3 + row, q); }
    }
};
template <class Epi, class Sched, bool ALIGN_EPI = false, bool SP2 = false>
__device__ __forceinline__ void gemm_phase(PG8_LAS unsigned char* lds, const Gemm g, const Sched& S, const Epi& E) {
    const int tid = threadIdx.x, wid = __builtin_amdgcn_readfirstlane(tid >> 6), lane = tid & 63, wr = wid >> 2, wc = wid & 3, fr = lane & 15, fq = lane >> 4;
    const int K = g.K, nt = K / BK;
    unsigned voffA[2], voffB[2];
#pragma unroll
    for (int i = 0; i < 2; ++i) { int R, C; stage_rc(tid * 16 + i * 8192, R, C); const int Rb = Epi::PERM ? ((R & ~31) + perm32(R & 31)) : R;
        voffA[i] = (unsigned)(R * K + C) * 2u; voffB[i] = (unsigned)(Rb * K + C) * 2u; }
    const size_t kstep = (size_t)(BK * 2);
    const size_t hstep = (size_t)HALF * K * 2;
    const size_t tstep = 2 * hstep;
    const unsigned ldsw = (unsigned)wid * 1024u;
    const int aoff = lds_byte(wr * 64 + fr, fq * 8), boff = lds_byte(wc * 32 + fr, fq * 8);
#define PG8_SA(b, h) (((b) * 2 + (h)) * HTB)
#define PG8_SB(b, h) ((4 + (b) * 2 + (h)) * HTB)
#define PG8_STAGE(bufoff, gbase, voff) do { _Pragma("unroll") for (int _i = 0; _i < 2; ++_i) \
        __builtin_amdgcn_global_load_lds((const unsigned*)((const char*)(gbase) + (voff)[_i]), (PG8_LAS unsigned*)(lds + (bufoff) + ldsw + _i * 8192), 16, 0, 0); } while (0)
#define PG8_LDA(dst, b, h) do { _Pragma("unroll") for (int m = 0; m < 4; ++m) _Pragma("unroll") for (int k = 0; k < 2; ++k) dst[m][k] = *(const PG8_LAS bf16x8*)(lds + PG8_SA(b, h) + aoff + m * 2048 + k * 1024); } while (0)
#define PG8_LDB(dst, b, h) do { _Pragma("unroll") for (int n = 0; n < 2; ++n) _Pragma("unroll") for (int k = 0; k < 2; ++k) dst[n][k] = *(const PG8_LAS bf16x8*)(lds + PG8_SB(b, h) + boff + n * 2048 + k * 1024); } while (0)
#define PG8_MMA(ai, bj, At, Bt) do { __builtin_amdgcn_s_setprio(1); _Pragma("unroll") for (int m = 0; m < 4; ++m) _Pragma("unroll") for (int n = 0; n < 2; ++n) _Pragma("unroll") for (int k = 0; k < 2; ++k) \
        acc[ai][bj][m][n] = __builtin_amdgcn_mfma_f32_16x16x32_bf16(Bt[n][k], At[m][k], acc[ai][bj][m][n], 0, 0, 0); __builtin_amdgcn_s_setprio(0); } while (0)
#define PG8_WAIT_V(n) asm volatile("s_waitcnt vmcnt(" #n ")" ::: "memory")
#define PG8_WAIT_L(n) asm volatile("s_waitcnt lgkmcnt(" #n ")" ::: "memory")
#define PG8_BAR __builtin_amdgcn_s_barrier()
#define PG8_SCHED __builtin_amdgcn_sched_barrier(0)
    Unit cur, nxt; int ui = 0;
    if (!S.next(0, cur)) return;
    f32x4 acc[2][2][4][2];
#pragma unroll
    for (int a = 0; a < 2; ++a)
#pragma unroll
        for (int b = 0; b < 2; ++b)
#pragma unroll
            for (int m = 0; m < 4; ++m)
#pragma unroll
                for (int n = 0; n < 2; ++n) acc[a][b][m][n] = (f32x4){0.f, 0.f, 0.f, 0.f};
    bf16x8 At[4][2], B0[2][2], B1[2][2];
    const char* cA = (const char*)g.A + (size_t)cur.pm * tstep; const char* cB = (const char*)g.Bt + (size_t)cur.pn * tstep;
    S.a_ready(cur);
    if constexpr (SP2) {
        PG8_STAGE(PG8_SB(0, 0), cB, voffB); PG8_STAGE(PG8_SB(0, 1), cB + hstep, voffB); PG8_STAGE(PG8_SA(0, 0), cA, voffA); PG8_STAGE(PG8_SA(0, 1), cA + hstep, voffA);
        if (wr == 1) PG8_BAR;
        PG8_WAIT_V(2); PG8_BAR;
        PG8_STAGE(PG8_SB(1, 0), cB + kstep, voffB); PG8_STAGE(PG8_SA(1, 0), cA + kstep, voffA); PG8_STAGE(PG8_SB(1, 1), cB + hstep + kstep, voffB);
        PG8_WAIT_V(6); PG8_BAR;
    } else {
        PG8_STAGE(PG8_SB(0, 0), cB, voffB); PG8_STAGE(PG8_SA(0, 0), cA, voffA); PG8_STAGE(PG8_SB(0, 1), cB + hstep, voffB); PG8_STAGE(PG8_SA(0, 1), cA + hstep, voffA);
        if (wr == 1) PG8_BAR;
        PG8_WAIT_V(4); PG8_BAR;
        PG8_STAGE(PG8_SB(1, 0), cB + kstep, voffB); PG8_STAGE(PG8_SA(1, 0), cA + kstep, voffA); PG8_STAGE(PG8_SB(1, 1), cB + hstep + kstep, voffB);
        PG8_WAIT_V(6); PG8_BAR;
    }
    for (;;) {
        const bool has_next = S.next(ui + 1, nxt);
        const char* nA = has_next ? (const char*)g.A + (size_t)nxt.pm * tstep : cA; const char* nB = has_next ? (const char*)g.Bt + (size_t)nxt.pn * tstep : cB;
        for (int t = 0; t < nt; t += 2) {
            const bool last = (t == nt - 2);
            if constexpr (Epi::MID) { if (t == Epi::MID_T) E.mid(acc, cur, wr, fr); }
            const char* a1 = cA + (size_t)(t + 1) * kstep;
            const char* a2 = last ? nA : cA + (size_t)(t + 2) * kstep; const char* b2 = last ? nB : cB + (size_t)(t + 2) * kstep;
            const char* a3 = a2 + kstep; const char* b3 = b2 + kstep;
            if (last && has_next) S.a_ready(nxt);
            if constexpr (SP2) {
            PG8_LDB(B0, 0, 0); PG8_LDB(B1, 0, 1); PG8_SCHED; PG8_LDA(At, 0, 0); PG8_STAGE(PG8_SA(1, 1), a1 + hstep, voffA);
            PG8_WAIT_V(8); PG8_WAIT_L(0); PG8_BAR; PG8_MMA(0, 0, At, B0); PG8_MMA(0, 1, At, B1); PG8_BAR; PG8_SCHED;
            PG8_LDA(At, 0, 1); PG8_STAGE(PG8_SB(0, 0), b2, voffB); PG8_STAGE(PG8_SB(0, 1), b2 + hstep, voffB); PG8_STAGE(PG8_SA(0, 0), a2, voffA);
            PG8_WAIT_V(8); PG8_WAIT_L(0); PG8_BAR; PG8_MMA(1, 0, At, B0); PG8_MMA(1, 1, At, B1); PG8_BAR; PG8_SCHED;
            PG8_LDB(B0, 1, 0); PG8_LDB(B1, 1, 1); PG8_SCHED; PG8_LDA(At, 1, 0); PG8_STAGE(PG8_SA(0, 1), a2 + hstep, voffA);
            PG8_WAIT_V(8); PG8_WAIT_L(0); PG8_BAR; PG8_MMA(0, 0, At, B0); PG8_MMA(0, 1, At, B1); PG8_BAR; PG8_SCHED;
            PG8_LDA(At, 1, 1); PG8_STAGE(PG8_SB(1, 0), b3, voffB); PG8_STAGE(PG8_SB(1, 1), b3 + hstep, voffB); PG8_STAGE(PG8_SA(1, 0), a3, voffA);
            PG8_WAIT_V(8); PG8_WAIT_L(0); PG8_BAR; PG8_MMA(1, 0, At, B0); PG8_MMA(1, 1, At, B1); PG8_BAR; PG8_SCHED;
            } else {
            PG8_LDB(B0, 0, 0); PG8_SCHED; PG8_LDA(At, 0, 0); PG8_STAGE(PG8_SA(1, 1), a1 + hstep, voffA);
            PG8_WAIT_L(8); PG8_BAR; PG8_WAIT_L(0); PG8_MMA(0, 0, At, B0); PG8_BAR; PG8_SCHED;
            PG8_LDB(B1, 0, 1); PG8_STAGE(PG8_SB(0, 0), b2, voffB);
            PG8_BAR; PG8_WAIT_L(0); PG8_MMA(0, 1, At, B1); PG8_BAR;
            PG8_LDA(At, 0, 1); PG8_STAGE(PG8_SA(0, 0), a2, voffA);
            PG8_BAR; PG8_WAIT_L(0); PG8_MMA(1, 0, At, B0); PG8_BAR; PG8_SCHED;
            PG8_STAGE(PG8_SB(0, 1), b2 + hstep, voffB);
            PG8_WAIT_V(6); PG8_BAR; PG8_MMA(1, 1, At, B1); PG8_BAR;
            PG8_LDB(B0, 1, 0); PG8_SCHED; PG8_LDA(At, 1, 0); PG8_STAGE(PG8_SA(0, 1), a2 + hstep, voffA);
            PG8_WAIT_L(8); PG8_BAR; PG8_WAIT_L(0); PG8_MMA(0, 0, At, B0); PG8_BAR; PG8_SCHED;
            PG8_LDB(B1, 1, 1); PG8_STAGE(PG8_SB(1, 0), b3, voffB);
            PG8_BAR; PG8_WAIT_L(0); PG8_MMA(0, 1, At, B1); PG8_BAR;
            PG8_LDA(At, 1, 1); PG8_STAGE(PG8_SA(1, 0), a3, voffA);
            PG8_BAR; PG8_WAIT_L(0); PG8_MMA(1, 0, At, B0); PG8_BAR; PG8_SCHED;
            PG8_STAGE(PG8_SB(1, 1), b3 + hstep, voffB);
            PG8_WAIT_V(6); PG8_BAR; PG8_MMA(1, 1, At, B1); PG8_BAR;
            }
        }
        if constexpr (ALIGN_EPI) { if (wr == 0) PG8_BAR; }
        if constexpr (!Epi::AFTER_DRAIN) { E(acc, cur, wr, wc, fr, fq); S.done(cur); }
        if (!has_next) break;
#pragma unroll
        for (int a = 0; a < 2; ++a)
#pragma unroll
            for (int b = 0; b < 2; ++b)
#pragma unroll
                for (int m = 0; m < 4; ++m)
#pragma unroll
                    for (int n = 0; n < 2; ++n) acc[a][b][m][n] = (f32x4){0.f, 0.f, 0.f, 0.f};
        cur = nxt; cA = nA; cB = nB; ++ui;
        if constexpr (ALIGN_EPI) { if (wr == 1) PG8_BAR; }
    }
    PG8_WAIT_V(0);
    if constexpr (!ALIGN_EPI) { if (wr == 0) PG8_BAR; }
    PG8_BAR;
    if constexpr (Epi::AFTER_DRAIN) { E.fused(acc, cur, wr, wc, fr, fq, lds, wid, lane); S.done(cur); }
#undef PG8_SA
#undef PG8_SB
#undef PG8_STAGE
#undef PG8_LDA
#undef PG8_LDB
#undef PG8_MMA
#undef PG8_WAIT_V
#undef PG8_WAIT_L
#undef PG8_BAR
#undef PG8_SCHED
}
}

__device__ __forceinline__ void transpose_item(const float* W, int N, bf16_t* WT, int Kd, int k_src0, int k_dst0, int n_src0, int n_dst0, const float* sc, LAS float* scr, int lane) {
#pragma unroll 8
    for (int i = 0; i < 32; ++i) { const int kk = 2 * i + (lane >> 5); float v = W[(size_t)(k_src0 + kk) * N + n_src0 + (lane & 31)]; if (sc) v *= sc[k_src0 + kk]; scr[kk * 33 + (lane & 31)] = v; }
    asm volatile("s_waitcnt lgkmcnt(0)" ::: "memory");
    const int c = lane & 7;
#pragma unroll
    for (int j = 0; j < 4; ++j) { const int n = (lane >> 3) + 8 * j; const LAS float* s = scr + (8 * c) * 33 + n;
        u32x4 o; o.x = pk2(s[0 * 33], s[1 * 33]); o.y = pk2(s[2 * 33], s[3 * 33]); o.z = pk2(s[4 * 33], s[5 * 33]); o.w = pk2(s[6 * 33], s[7 * 33]);
        *(u32x4*)(WT + (size_t)(n_dst0 + n) * Kd + k_dst0 + 8 * c) = o; }
    asm volatile("s_waitcnt lgkmcnt(0)" ::: "memory");
}

__device__ __forceinline__ void p0_prologue(const Params& p, LAS unsigned char* lds, int bid, int nb) {
    const int tid = threadIdx.x, lane = tid & 63, wave = tid >> 6;
    LAS float* scr = (LAS float*)(lds + wave * 16384);
    const int gw = bid * NWAVES + wave, NGW = nb * NWAVES;
    bf16_t* Win_t = (bf16_t*)(p.ws + WS_WIN); bf16_t* Wout_t = (bf16_t*)(p.ws + WS_WOUT); bf16_t* Wgu_t = (bf16_t*)(p.ws + WS_WGU); bf16_t* Wdn_t = (bf16_t*)(p.ws + WS_WDN);
    constexpr int I_IN = (D / 64) * (DIN / 32), I_OUT = (D / 64) * (D / 32), I_GU = (D / 64) * (2 * DFF / 32), I_DN = (DFF / 64) * (D / 32);
    constexpr int NITEMS = I_IN + I_OUT + I_GU + I_DN;
    for (int it = gw; it < NITEMS; it += NGW) {
        int r = it;
        if (r < I_IN) { const int nblk = DIN / 32, kb = r / nblk, nbk = r % nblk; transpose_item(p.w_in, DIN, Win_t, D, 64 * kb, 64 * kb, 32 * nbk, 32 * nbk, nullptr, scr, lane); continue; } r -= I_IN;
        if (r < I_OUT) { const int nblk = D / 32, kb = r / nblk, nbk = r % nblk; const int ks = 64 * kb;
            transpose_item(p.w_out, D, Wout_t, D, ks, (ks + 512) & 1023, 32 * nbk, 32 * nbk, ks >= 512 ? p.att_norm_w - 512 : nullptr, scr, lane); continue; } r -= I_OUT;
        if (r < I_GU) { const int nblk = 2 * DFF / 32, kb = r / nblk, nbk = r % nblk; const int nd = 32 * nbk, pn = nd >> 8, nn = nd & 255;
            const int ns = nn < 128 ? 128 * pn + nn : DFF + 128 * pn + nn - 128;
            transpose_item(p.w_gate_up, 2 * DFF, Wgu_t, D, 64 * kb, 64 * kb, ns, nd, p.norm2_w, scr, lane); continue; } r -= I_GU;
        { const int nblk = D / 32, kb = r / nblk, nbk = r % nblk; transpose_item(p.w_down, D, Wdn_t, DFF, 64 * kb, 64 * kb, 32 * nbk, 32 * nbk, nullptr, scr, lane); }
    }
    bf16_t* XN = (bf16_t*)(p.ws + WS_XN);
    for (int m = gw; m < M; m += NGW) {
        const f32x4* xr = (const f32x4*)(p.x + (size_t)m * D) + lane; const f32x4* wr = (const f32x4*)p.norm1_w + lane;
        f32x4 v[4]; float s = 0.f;
#pragma unroll
        for (int j = 0; j < 4; ++j) { v[j] = xr[64 * j]; s += (v[j].x * v[j].x + v[j].y * v[j].y) + (v[j].z * v[j].z + v[j].w * v[j].w); }
        const float rstd = 1.f / sqrtf(wave_sum(s) * (1.f / D) + EPS);
        unsigned long long* o8 = (unsigned long long*)(XN + (size_t)m * D) + lane;
#pragma unroll
        for (int j = 0; j < 4; ++j) { const f32x4 w = wr[64 * j]; o8[64 * j] = (unsigned long long)pk2(v[j].x * rstd * w.x, v[j].y * rstd * w.y) | ((unsigned long long)pk2(v[j].z * rstd * w.z, v[j].w * rstd * w.w) << 32); }
    }
    if (bid == 0) { float* LB = (float*)(p.ws + WS_CTL + CTL_LB);
        for (int j = tid; j < 1024; j += NTHREADS) { const int d = j >> 9, jj = j & 511; const float a0 = p.lb_logits[d * 1024 + jj], a1 = p.lb_logits[d * 1024 + 512 + jj]; LB[j] = 1.f / (1.f + expf(a1 - a0)); } }
}

struct EpiIn {
    static constexpr bool PAIR = false, MID = false;
    bf16_t* QH; float* ZF; bf16_t* IV; bf16_t* GH; float* AQKV; const float* LB;
    __device__ __forceinline__ void elem(int row, int col, float v) const {
        if (col < 512) QH[(size_t)row * 512 + col] = (bf16_t)f2bf(silu_f(v));
        else if (col < 1536) { const int c = col - 512; const float lb = LB[c]; ZF[(size_t)row * 1024 + c] = lb + (1.f - lb) * sigmoid_f(v); }
        else if (col < 2048) IV[(size_t)row * 512 + col - 1536] = (bf16_t)f2bf(v);
        else if (col < 2560) GH[(size_t)row * 512 + col - 2048] = (bf16_t)f2bf(silu_f(v));
        else AQKV[(size_t)row * 768 + col - 2560] = v;
    }
    __device__ __forceinline__ void naive(f32x16 (&acc)[2][2], int row0, int col0, int cs, int r32, int hi) const {
#pragma unroll
        for (int i = 0; i < 2; ++i)
#pragma unroll
            for (int j = 0; j < 2; ++j)
#pragma unroll
                for (int r = 0; r < 16; ++r) elem(row0 + 32 * i + crow(r, hi), col0 + j * cs + r32, acc[i][j][r]);
    }
    __device__ __forceinline__ void mid(f32x16 (&)[2][2], int, int, int) const {}
};
struct EpiOut {
    static constexpr bool PAIR = false, MID = true; static constexpr int MIDK = 512;
    const float* x; float* out; bf16_t* XB; float* ss2; const float* ssatt;
    __device__ __forceinline__ void mid(f32x16 (&acc)[2][2], int row0, int r32, int hi) const {
#pragma unroll
        for (int i = 0; i < 2; ++i)
#pragma unroll
            for (int r = 0; r < 16; ++r) { const float s = 1.f / sqrtf(ssatt[row0 + 32 * i + crow(r, hi)] * (1.f / 512.f) + EPS); acc[i][0][r] *= s; acc[i][1][r] *= s; }
    }
    __device__ __forceinline__ void naive(f32x16 (&acc)[2][2], int row0, int col0, int cs, int r32, int hi) const {
#pragma unroll
        for (int i = 0; i < 2; ++i)
#pragma unroll
            for (int r = 0; r < 16; ++r) { const int row = row0 + 32 * i + crow(r, hi); float q = 0.f;
#pragma unroll
                for (int j = 0; j < 2; ++j) { const size_t idx = (size_t)row * D + col0 + j * cs + r32; const float v = x[idx] + acc[i][j][r]; out[idx] = v; XB[idx] = (bf16_t)f2bf(v); q += v * v; }
#pragma unroll
                for (int o = 1; o < 32; o <<= 1) q += __shfl_xor(q, o);
                if (r32 == 0) atomicAdd(ss2 + row, q); }
    }
};
struct EpiGU {
    static constexpr bool PAIR = true, MID = false;
    bf16_t* H; const float* ss2;
    __device__ __forceinline__ void naive(f32x16 (&acc)[2][2], int row0, int col0, int cs, int r32, int hi) const {
        const int pn = col0 >> 8, cc = (col0 & 255) + r32;
#pragma unroll
        for (int i = 0; i < 2; ++i)
#pragma unroll
            for (int r = 0; r < 16; ++r) { const int row = row0 + 32 * i + crow(r, hi); const float s = 1.f / sqrtf(ss2[row] * (1.f / D) + EPS);
                H[(size_t)row * DFF + 128 * pn + cc] = (bf16_t)f2bf(silu_f(acc[i][0][r] * s) * (acc[i][1][r] * s)); }
    }
    __device__ __forceinline__ void mid(f32x16 (&)[2][2], int, int, int) const {}
};
struct EpiDown {
    static constexpr bool PAIR = false, MID = false;
    float* out; float* ss3;
    __device__ __forceinline__ void naive(f32x16 (&acc)[2][2], int row0, int col0, int cs, int r32, int hi) const {
#pragma unroll
        for (int i = 0; i < 2; ++i)
#pragma unroll
            for (int r = 0; r < 16; ++r) { const int row = row0 + 32 * i + crow(r, hi); float q = 0.f;
#pragma unroll
                for (int j = 0; j < 2; ++j) { const size_t idx = (size_t)row * D + col0 + j * cs + r32; const float v = out[idx] + acc[i][j][r]; out[idx] = v; q += v * v; }
#pragma unroll
                for (int o = 1; o < 32; o <<= 1) q += __shfl_xor(q, o);
                if (r32 == 0) atomicAdd(ss3 + row, q); }
    }
    __device__ __forceinline__ void mid(f32x16 (&)[2][2], int, int, int) const {}
};

template <class Epi>
__device__ __forceinline__ void ngemm_phase(const bf16_t* A, const bf16_t* Bt, int M_, int N_, int K_, const Epi& E, int bid, int nb) {
    const int tid = threadIdx.x, lane = tid & 63, wid = tid >> 6, r32 = lane & 31, hi = lane >> 5, wr = wid >> 2, wc = wid & 3;
    const int nM = M_ / 128, nN = N_ / 256; constexpr int CS = Epi::PAIR ? 128 : 32;
    for (int u = bid; u < nM * nN; u += nb) {
        const int pm = u / nN, pn = u % nN;
        const int row0 = pm * 128 + wr * 64, col0 = pn * 256 + (Epi::PAIR ? wc * 32 : wc * 64);
        f32x16 acc[2][2];
#pragma unroll
        for (int i = 0; i < 2; ++i)
#pragma unroll
            for (int j = 0; j < 2; ++j)
#pragma unroll
                for (int r = 0; r < 16; ++r) acc[i][j][r] = 0.f;
        const bf16_t* a0 = A + (size_t)(row0 + r32) * K_ + hi * 8; const bf16_t* a1 = a0 + (size_t)32 * K_;
        const bf16_t* b0 = Bt + (size_t)(col0 + r32) * K_ + hi * 8; const bf16_t* b1 = b0 + (size_t)CS * K_;
        for (int k = 0; k < K_; k += 16) {
            if constexpr (Epi::MID) { if (k == Epi::MIDK) E.mid(acc, row0, r32, hi); }
            const bf16x8 fa0 = *(const bf16x8*)(a0 + k), fa1 = *(const bf16x8*)(a1 + k), fb0 = *(const bf16x8*)(b0 + k), fb1 = *(const bf16x8*)(b1 + k);
            acc[0][0] = __builtin_amdgcn_mfma_f32_32x32x16_bf16(fa0, fb0, acc[0][0], 0, 0, 0);
            acc[0][1] = __builtin_amdgcn_mfma_f32_32x32x16_bf16(fa0, fb1, acc[0][1], 0, 0, 0);
            acc[1][0] = __builtin_amdgcn_mfma_f32_32x32x16_bf16(fa1, fb0, acc[1][0], 0, 0, 0);
            acc[1][1] = __builtin_amdgcn_mfma_f32_32x32x16_bf16(fa1, fb1, acc[1][1], 0, 0, 0);
        }
        E.naive(acc, row0, col0, CS, r32, hi);
    }
}

__device__ __forceinline__ void rope_pair(float x1, float x2, int pi  , int t, float& o1, float& o2) {
    const int pos = pi < 16 ? (t >> 6) : (t & 63); const int fi = pi & 15;
    const float freq = exp2f(-(float)fi * (13.287712379549449f / 16.f));
    const float ang = (float)pos * freq; float rev = ang * 0.15915494309189535f; rev -= rintf(rev);
    const float s = __builtin_amdgcn_sinf(rev), c = __builtin_amdgcn_cosf(rev);
    o1 = x1 * c - x2 * s; o2 = x1 * s + x2 * c;
}
__device__ __forceinline__ void p2_qkconvert(const Params& p, int bid, int nb) {
    const int tid = threadIdx.x, lane = tid & 63, wave = tid >> 6; const int gw = bid * NWAVES + wave, NGW = nb * NWAVES;
    const float* AQKV = (const float*)(p.ws + WS_AQKV); bf16_t* QA = (bf16_t*)(p.ws + WS_QA); bf16_t* KA = (bf16_t*)(p.ws + WS_KA); bf16_t* VA = (bf16_t*)(p.ws + WS_VA); bf16_t* VT = (bf16_t*)(p.ws + WS_VT);
    const int pi = lane & 31;
    const f32x2 qw = *((const f32x2*)p.q_norm_w + pi), kw = *((const f32x2*)p.k_norm_w + pi);
    for (int m = gw; m < M; m += NGW) {
        const int t = m & (SEQ - 1), b = m >> 13; const float* row = AQKV + (size_t)m * 768;
#pragma unroll
        for (int j = 0; j < 4; ++j) {
            const f32x2 v = *((const f32x2*)row + 64 * j + lane); float ss = v.x * v.x + v.y * v.y;
#pragma unroll
            for (int o = 1; o < 32; o <<= 1) ss += __shfl_xor(ss, o);
            const float rstd = 1.f / sqrtf(ss * (1.f / 64.f) + EPS); float o1, o2; rope_pair(v.x * rstd * qw.x, v.y * rstd * qw.y, pi, t, o1, o2);
            *((unsigned*)(QA + (size_t)m * 512) + 64 * j + lane) = pk2(o1 * C2, o2 * C2);
        }
        {
            const f32x2 v = *((const f32x2*)(row + 512) + lane); float ss = v.x * v.x + v.y * v.y;
#pragma unroll
            for (int o = 1; o < 32; o <<= 1) ss += __shfl_xor(ss, o);
            const float rstd = 1.f / sqrtf(ss * (1.f / 64.f) + EPS); float o1, o2; rope_pair(v.x * rstd * kw.x, v.y * rstd * kw.y, pi, t, o1, o2);
            *((unsigned*)(KA + (size_t)m * 128) + lane) = pk2(o1, o2);
        }
        {
            const f32x2 v = *((const f32x2*)(row + 640) + lane); const unsigned w = pk2(v.x, v.y);
            *((unsigned*)(VA + (size_t)m * 128) + lane) = w;
            const int kvh = lane >> 5, d = 2 * (lane & 31);
            bf16_t* vt = VT + ((size_t)(b * 2 + kvh) * 64 + d) * SEQ + t; vt[0] = (bf16_t)(w & 0xffffu); vt[SEQ] = (bf16_t)(w >> 16);
        }
    }
}

__device__ __forceinline__ void nattn_unit(const bf16_t* QA, const bf16_t* KA, const bf16_t* VT, bf16_t* MIX, float* ssatt, int wu, int lane) {
    const int r32 = lane & 31, hi = lane >> 5; const int b = wu >> 11, hq = (wu >> 8) & 7, qb = wu & 255, kvh = hq >> 2;
    const size_t rowbase = (size_t)b * SEQ;
    const bf16_t* Qp = QA + (rowbase + qb * 32 + r32) * 512 + hq * 64 + hi * 8;
    bf16x8 qf[4];
#pragma unroll
    for (int d0 = 0; d0 < 4; ++d0) qf[d0] = *(const bf16x8*)(Qp + d0 * 16);
    const bf16_t* Kp = KA + (rowbase + r32) * 128 + kvh * 64 + hi * 8;
    const bf16_t* Vp = VT + ((size_t)(b * 2 + kvh) * 64 + r32) * SEQ + 4 * hi;
    f32x16 o0, o1;
#pragma unroll
    for (int r = 0; r < 16; ++r) { o0[r] = 0.f; o1[r] = 0.f; }
    float mrun = -1e30f, l = 0.f;
    for (int kv0 = 0; kv0 < SEQ; kv0 += 32) {
        f32x16 s;
#pragma unroll
        for (int r = 0; r < 16; ++r) s[r] = 0.f;
#pragma unroll
        for (int d0 = 0; d0 < 4; ++d0) { const bf16x8 kf = *(const bf16x8*)(Kp + (size_t)kv0 * 128 + d0 * 16); s = __builtin_amdgcn_mfma_f32_32x32x16_bf16(kf, qf[d0], s, 0, 0, 0); }
        float mx = s[0];
#pragma unroll
        for (int r = 1; r < 16; ++r) mx = fmaxf(mx, s[r]);
        mx = fmaxf(mx, __shfl_xor(mx, 32));
        const float mn = fmaxf(mrun, mx), alpha = __builtin_amdgcn_exp2f(mrun - mn); mrun = mn;
        float ps = 0.f;
#pragma unroll
        for (int r = 0; r < 16; ++r) { s[r] = __builtin_amdgcn_exp2f(s[r] - mn); ps += s[r]; }
        l = l * alpha + ps;
#pragma unroll
        for (int r = 0; r < 16; ++r) { o0[r] *= alpha; o1[r] *= alpha; }
#pragma unroll
        for (int si = 0; si < 2; ++si) {
            u32x4 pw; pw.x = pk2(s[8 * si + 0], s[8 * si + 1]); pw.y = pk2(s[8 * si + 2], s[8 * si + 3]); pw.z = pk2(s[8 * si + 4], s[8 * si + 5]); pw.w = pk2(s[8 * si + 6], s[8 * si + 7]);
            const bf16x8 pb = __builtin_bit_cast(bf16x8, pw);
            const bf16_t* vp = Vp + kv0 + 16 * si;
            { const bf16x4 lo = *(const bf16x4*)vp, h4 = *(const bf16x4*)(vp + 8); const bf16x8 vf = {lo[0], lo[1], lo[2], lo[3], h4[0], h4[1], h4[2], h4[3]}; o0 = __builtin_amdgcn_mfma_f32_32x32x16_bf16(vf, pb, o0, 0, 0, 0); }
            { const bf16_t* vq = vp + (size_t)32 * SEQ; const bf16x4 lo = *(const bf16x4*)vq, h4 = *(const bf16x4*)(vq + 8); const bf16x8 vf = {lo[0], lo[1], lo[2], lo[3], h4[0], h4[1], h4[2], h4[3]}; o1 = __builtin_amdgcn_mfma_f32_32x32x16_bf16(vf, pb, o1, 0, 0, 0); }
        }
    }
    l += __shfl_xor(l, 32); const float rl = 1.f / l; const size_t row = rowbase + qb * 32 + r32; float q = 0.f;
#pragma unroll
    for (int r = 0; r < 16; ++r) { const float a = o0[r] * rl, c = o1[r] * rl; q += a * a + c * c;
        MIX[row * 1024 + hq * 64 + crow(r, hi)] = (bf16_t)f2bf(a); MIX[row * 1024 + hq * 64 + 32 + crow(r, hi)] = (bf16_t)f2bf(c); }
    q += __shfl_xor(q, 32);
    if (hi == 0) atomicAdd(ssatt + row, q);
}

namespace hg {
constexpr int RS = 136, RS2 = 72, OLS = 132;
constexpr int QB_OFF = 0, QI_OFF = 17408, KI_OFF = 34816, KCT_OFF = 52224, VT_OFF = 70656, SPT_OFF = 89088, PP_OFF = 123904, SEGT_OFF = 133120, DEC_OFF = 135168, HG_LDS = 135680;
static_assert(HG_LDS <= LDS_BYTES && 64 * OLS * 4 <= KI_OFF, "hgrn lds map");
constexpr int NSC = 32;
#define HG_BAR() do { asm volatile("s_waitcnt vmcnt(0) lgkmcnt(0)" ::: "memory"); __builtin_amdgcn_s_barrier(); asm volatile("" ::: "memory"); } while (0)
#define HG_LD8(off, row, rs, col) (*(const LAS bf16x8*)(lds + (off) + ((row) * (rs) + (col)) * 2))

template <int DIR, bool OUT>
__device__ __forceinline__ void chunk_step(const Params& p, LAS unsigned char* lds, int b, int h, int chunk, f32x16 (&S)[2], f32x16& o, float& tsum) {
    const int tid = threadIdx.x, lane = tid & 63, wid = tid >> 6, r32 = lane & 31, hi = lane >> 5, c = tid & 127, seg = tid >> 7;
    const size_t r0 = (size_t)b * SEQ + chunk * 64 + seg * 16;
    const float* zf = (const float*)(p.ws + WS_ZF) + r0 * 1024 + DIR * 512 + h * 128 + c;
    const bf16_t* qh = (const bf16_t*)(p.ws + WS_QH) + r0 * 512 + h * 128 + c;
    const bf16_t* iv = (const bf16_t*)(p.ws + WS_IV) + r0 * 512 + h * 128 + c;
    LAS float* SEGT = (LAS float*)(lds + SEGT_OFF); LAS float* DEC = (LAS float*)(lds + DEC_OFF);
    float lf[16], kk[16], qv[16]; unsigned vraw[16];
#pragma unroll
    for (int j = 0; j < 16; ++j) { lf[j] = zf[(size_t)j * 1024]; vraw[j] = iv[(size_t)j * 512]; if (OUT) qv[j] = bf2f(qh[(size_t)j * 512]); }
#pragma unroll
    for (int j = 0; j < 16; ++j) { kk[j] = 1.f - lf[j]; lf[j] = __logf(lf[j]); }
    if (DIR == 0) {
#pragma unroll
        for (int j = 1; j < 16; ++j) lf[j] += lf[j - 1];
        SEGT[seg * 128 + c] = lf[15];
    } else {
#pragma unroll
        for (int j = 14; j >= 0; --j) lf[j] += lf[j + 1];
        SEGT[seg * 128 + c] = lf[0];
    }
    HG_BAR();
    const float t0 = SEGT[c], t1 = SEGT[128 + c], t2 = SEGT[256 + c], t3 = SEGT[384 + c];
    const float total = (t0 + t1) + (t2 + t3);
    const float off = DIR == 0 ? (seg == 0 ? 0.f : seg == 1 ? t0 : seg == 2 ? t0 + t1 : t0 + t1 + t2) : (seg == 3 ? 0.f : seg == 2 ? t3 : seg == 1 ? t2 + t3 : t1 + t2 + t3);
    const float bref = DIR == 0 ? t0 + t1 : t2 + t3;
    unsigned kcw[8], vw[8];
#pragma unroll
    for (int j = 0; j < 16; j += 2) {
        const float b0 = lf[j] + off, b1 = lf[j + 1] + off;
        kcw[j >> 1] = pk2(kk[j] * __expf(total - b0), kk[j + 1] * __expf(total - b1));
        vw[j >> 1] = vraw[j] | (vraw[j + 1] << 16);
        if (OUT) {
            const int row0 = (seg * 16 + j) * RS + c, row1 = row0 + RS;
            ((LAS bf16_t*)(lds + QB_OFF))[row0] = (bf16_t)f2bf(qv[j] * __expf(b0)); ((LAS bf16_t*)(lds + QB_OFF))[row1] = (bf16_t)f2bf(qv[j + 1] * __expf(b1));
            ((LAS bf16_t*)(lds + QI_OFF))[row0] = (bf16_t)f2bf(qv[j] * __expf(b0 - bref)); ((LAS bf16_t*)(lds + QI_OFF))[row1] = (bf16_t)f2bf(qv[j + 1] * __expf(b1 - bref));
            ((LAS bf16_t*)(lds + KI_OFF))[row0] = (bf16_t)f2bf(kk[j] * __expf(bref - b0)); ((LAS bf16_t*)(lds + KI_OFF))[row1] = (bf16_t)f2bf(kk[j + 1] * __expf(bref - b1));
        }
    }
    { LAS u32x4* kd = (LAS u32x4*)(lds + KCT_OFF + (c * RS2 + seg * 16) * 2); kd[0] = (u32x4){kcw[0], kcw[1], kcw[2], kcw[3]}; kd[1] = (u32x4){kcw[4], kcw[5], kcw[6], kcw[7]};
      LAS u32x4* vd = (LAS u32x4*)(lds + VT_OFF + (c * RS2 + seg * 16) * 2); vd[0] = (u32x4){vw[0], vw[1], vw[2], vw[3]}; vd[1] = (u32x4){vw[4], vw[5], vw[6], vw[7]}; }
    if (seg == 0) DEC[c] = __expf(total);
    tsum += total;
    const int cb = 2 * (wid >> 2), vb = wid & 3;
    if (OUT) {
#pragma unroll
        for (int i = 0; i < 2; ++i)
#pragma unroll
            for (int g = 0; g < 4; ++g) { u32x2 w; w.x = pk2(S[i][4 * g], S[i][4 * g + 1]); w.y = pk2(S[i][4 * g + 2], S[i][4 * g + 3]);
                *(LAS u32x2*)(lds + SPT_OFF + ((32 * vb + r32) * RS + 32 * (cb + i) + 8 * g + 4 * hi) * 2) = w; }
    }
    HG_BAR();
    if (OUT) {
        if (wid < 4) { const int tb = wid >> 1, sb = wid & 1; const bool skip = DIR == 0 ? (tb == 0 && sb == 1) : (tb == 1 && sb == 0);
            f32x16 sc;
#pragma unroll
            for (int r = 0; r < 16; ++r) sc[r] = 0.f;
            if (!skip) {
#pragma unroll
                for (int k8 = 0; k8 < 8; ++k8) sc = __builtin_amdgcn_mfma_f32_32x32x16_bf16(HG_LD8(QI_OFF, 32 * tb + r32, RS, 16 * k8 + 8 * hi), HG_LD8(KI_OFF, 32 * sb + r32, RS, 16 * k8 + 8 * hi), sc, 0, 0, 0);
            }
#pragma unroll
            for (int r = 0; r < 16; ++r) { const int t = 32 * tb + crow(r, hi), s = 32 * sb + r32; const bool keep = DIR == 0 ? s <= t : s >= t;
                ((LAS bf16_t*)(lds + PP_OFF))[t * RS2 + s] = keep ? (bf16_t)f2bf(sc[r]) : (bf16_t)0; }
        }
        HG_BAR();
        { const int tb = wid >> 2;
#pragma unroll
            for (int r = 0; r < 16; ++r) o[r] = 0.f;
#pragma unroll
            for (int k8 = 0; k8 < 8; ++k8) o = __builtin_amdgcn_mfma_f32_32x32x16_bf16(HG_LD8(QB_OFF, 32 * tb + r32, RS, 16 * k8 + 8 * hi), HG_LD8(SPT_OFF, 32 * vb + r32, RS, 16 * k8 + 8 * hi), o, 0, 0, 0);
#pragma unroll
            for (int k4 = 0; k4 < 4; ++k4) o = __builtin_amdgcn_mfma_f32_32x32x16_bf16(HG_LD8(PP_OFF, 32 * tb + r32, RS2, 16 * k4 + 8 * hi), HG_LD8(VT_OFF, 32 * vb + r32, RS2, 16 * k4 + 8 * hi), o, 0, 0, 0);
        }
    }
#pragma unroll
    for (int i = 0; i < 2; ++i) { const int c0 = 32 * (cb + i);
#pragma unroll
        for (int r = 0; r < 16; ++r) S[i][r] *= DEC[c0 + crow(r, hi)];
#pragma unroll
        for (int k4 = 0; k4 < 4; ++k4) S[i] = __builtin_amdgcn_mfma_f32_32x32x16_bf16(HG_LD8(KCT_OFF, c0 + r32, RS2, 16 * k4 + 8 * hi), HG_LD8(VT_OFF, 32 * vb + r32, RS2, 16 * k4 + 8 * hi), S[i], 0, 0, 0);
    }
}

template <int DIR>
__device__ __forceinline__ void pass1_unit(const Params& p, LAS unsigned char* lds, int b, int h, int sc) {
    const int tid = threadIdx.x, lane = tid & 63, wid = tid >> 6;
    f32x16 S[2]; f32x16 odummy; float tsum = 0.f;
#pragma unroll
    for (int i = 0; i < 2; ++i)
#pragma unroll
        for (int r = 0; r < 16; ++r) S[i][r] = 0.f;
    for (int ci = 0; ci < 4; ++ci) chunk_step<DIR, false>(p, lds, b, h, sc * 4 + (DIR ? 3 - ci : ci), S, odummy, tsum);
    const size_t seq = (size_t)((DIR * 2 + b) * 4 + h) * NSC + sc;
    float* send = (float*)(p.ws + WS_SEND) + seq * 16384;
#pragma unroll
    for (int i = 0; i < 2; ++i)
#pragma unroll
        for (int r = 0; r < 16; ++r) send[((wid * 2 + i) * 16 + r) * 64 + lane] = S[i][r];
    if (tid < 128) ((float*)(p.ws + WS_DTOT))[seq * 128 + tid] = __expf(tsum);
    HG_BAR();
}

__device__ __forceinline__ void scan_phase(const Params& p, int bid, int nb) {
    float* SEND = (float*)(p.ws + WS_SEND); const float* DTOT = (const float*)(p.ws + WS_DTOT);
    for (int idx = bid * NTHREADS + threadIdx.x; idx < 16 * 16384; idx += nb * NTHREADS) {
        const int sq = idx >> 14, e = idx & 16383, dir = sq >> 3; const int ln = e & 63, reg = (e >> 6) & 15, i = (e >> 10) & 1, w = e >> 11;
        const int c = 32 * (2 * (w >> 2) + i) + crow(reg, ln >> 5);
        float* base = SEND + (size_t)sq * NSC * 16384 + e; const float* dt = DTOT + (size_t)sq * NSC * 128 + c;
        float run = 0.f;
        if (dir == 0) { for (int sc = 0; sc < NSC; ++sc) { const float end = base[(size_t)sc * 16384]; base[(size_t)sc * 16384] = run; run = dt[sc * 128] * run + end; } }
        else { for (int sc = NSC - 1; sc >= 0; --sc) { const float end = base[(size_t)sc * 16384]; base[(size_t)sc * 16384] = run; run = dt[sc * 128] * run + end; } }
    }
}

__device__ __forceinline__ void pass2_unit(const Params& p, LAS unsigned char* lds, int b, int h, int sc) {
    const int tid = threadIdx.x, lane = tid & 63, wid = tid >> 6, r32 = lane & 31, hi = lane >> 5;
    f32x16 S[2]; float tsum = 0.f;
    unsigned* ofw = (unsigned*)(p.ws + WS_OFW) + (size_t)blockIdx.x * 16384 + wid * 512 + lane;
    { const float* send = (const float*)(p.ws + WS_SEND) + ((size_t)((0 * 2 + b) * 4 + h) * NSC + sc) * 16384;
#pragma unroll
      for (int i = 0; i < 2; ++i)
#pragma unroll
          for (int r = 0; r < 16; ++r) S[i][r] = send[((wid * 2 + i) * 16 + r) * 64 + lane]; }
#pragma unroll 1
    for (int ci = 0; ci < 4; ++ci) { f32x16 o; chunk_step<0, true>(p, lds, b, h, sc * 4 + ci, S, o, tsum);
#pragma unroll
        for (int k = 0; k < 8; ++k) ofw[ci * 4096 + k * 64] = pk2(o[2 * k], o[2 * k + 1]); }
    { const float* send = (const float*)(p.ws + WS_SEND) + ((size_t)((1 * 2 + b) * 4 + h) * NSC + sc) * 16384;
#pragma unroll
      for (int i = 0; i < 2; ++i)
#pragma unroll
          for (int r = 0; r < 16; ++r) S[i][r] = send[((wid * 2 + i) * 16 + r) * 64 + lane]; }
    const bf16_t* GH = (const bf16_t*)(p.ws + WS_GH); bf16_t* MIX = (bf16_t*)(p.ws + WS_MIX);
#pragma unroll 1
    for (int cj = 0; cj < 4; ++cj) { const int ci = 3 - cj; f32x16 o;
        chunk_step<1, true>(p, lds, b, h, sc * 4 + ci, S, o, tsum);
#pragma unroll
        for (int k = 0; k < 8; ++k) { const unsigned w = ofw[ci * 4096 + k * 64]; o[2 * k] += __builtin_bit_cast(float, w << 16); o[2 * k + 1] += __builtin_bit_cast(float, w & 0xffff0000u); }
        HG_BAR();
        LAS float* OL = (LAS float*)lds; const int tb = wid >> 2, vb = wid & 3;
#pragma unroll
        for (int r = 0; r < 16; ++r) OL[(32 * tb + crow(r, hi)) * OLS + 32 * vb + r32] = o[r];
        HG_BAR();
        { const int tt = tid >> 3, sg = tid & 7; const size_t row = (size_t)b * SEQ + (sc * 4 + ci) * 64 + tt; float tot[16]; float ss = 0.f;
#pragma unroll
          for (int j = 0; j < 16; j += 4) { const f32x4 v = *(const LAS f32x4*)(OL + tt * OLS + sg * 16 + j); tot[j] = v.x; tot[j + 1] = v.y; tot[j + 2] = v.z; tot[j + 3] = v.w; ss += (v.x * v.x + v.y * v.y) + (v.z * v.z + v.w * v.w); }
          ss += __shfl_xor(ss, 1); ss += __shfl_xor(ss, 2); ss += __shfl_xor(ss, 4);
          const float rstd = 1.f / sqrtf(ss * (1.f / 128.f) + EPS);
          const u32x4 g0 = *(const u32x4*)(GH + row * 512 + h * 128 + sg * 16), g1 = *(const u32x4*)(GH + row * 512 + h * 128 + sg * 16 + 8);
          const unsigned gw[8] = {g0.x, g0.y, g0.z, g0.w, g1.x, g1.y, g1.z, g1.w}; unsigned ow[8];
#pragma unroll
          for (int j = 0; j < 16; j += 2) { const float w0 = p.hg_norm_w[sg * 16 + j], w1 = p.hg_norm_w[sg * 16 + j + 1]; const unsigned g = gw[j >> 1];
              ow[j >> 1] = pk2(tot[j] * rstd * w0 * __builtin_bit_cast(float, g << 16), tot[j + 1] * rstd * w1 * __builtin_bit_cast(float, g & 0xffff0000u)); }
          u32x4* dst = (u32x4*)(MIX + row * 1024 + 512 + h * 128 + sg * 16); dst[0] = (u32x4){ow[0], ow[1], ow[2], ow[3]}; dst[1] = (u32x4){ow[4], ow[5], ow[6], ow[7]}; }
    }
    HG_BAR();
}
#undef HG_BAR
#undef HG_LD8
}

#include <hip/hip_bf16.h>
#include <cmath>
namespace attn_body {
using bf16=__hip_bfloat16;
using bf16x8=__attribute__((ext_vector_type(8)))short;
using s16x4=__attribute__((ext_vector_type(4)))short;
using f32x16=__attribute__((ext_vector_type(16)))float;
using u32x4=__attribute__((ext_vector_type(4)))unsigned;
constexpr int BATCH=2,NHEAD=8,NKV=2,SEQ=8192,D=64,QP=512,KP=128,OP=1024;
constexpr int NW=8,QBLK=32,QB=QBLK*NW,KVBLK=64,NQB=SEQ/QB;
constexpr int ATTN_UNIT_ROWS=QB;
__device__ __forceinline__ int crow(int r,int hi){return (r&3)+8*(r>>2)+4*hi;}
#define SBAR() __builtin_amdgcn_sched_barrier(0)
__device__ __forceinline__ void cmask(f32x16&p0,f32x16&p1,int jb,int qrel,int hi){
  const float NEG=-INFINITY; int kb=64*jb+4*hi;
  #pragma unroll
  for(int r=0;r<16;++r){int kv=kb+(r&3)+8*(r>>2); if(kv>qrel)p0[r]=NEG; if(kv+32>qrel)p1[r]=NEG;}
}

constexpr int NSLOT=3, SLOTB=8192;
constexpr int LDS_K=0, LDS_V=NSLOT*SLOTB, LDS_WS=2*NSLOT*SLOTB, LDS_OST=LDS_WS+NW*64*4, LDS_BYTES=LDS_OST+NW*4096;
constexpr float C2=0.125f*1.4426950408889634f;
__device__ __forceinline__ void glds16(const void*gsrc,unsigned lds_dst){unsigned keep;
  asm volatile("s_mov_b32 %0, m0\n\ts_mov_b32 m0, %2\n\ts_nop 0\n\tglobal_load_lds_dwordx4 %1, off\n\ts_mov_b32 m0, %0":"=&s"(keep):"v"(gsrc),"s"(lds_dst):"memory");}
__device__ __forceinline__ float max3f(float a,float b,float c){float r;asm("v_max3_f32 %0, %1, %2, %3":"=v"(r):"v"(a),"v"(b),"v"(c));return r;}
__device__ __forceinline__ float max2f(float a,float b){float r;asm("v_max_f32_e32 %0, %1, %2":"=v"(r):"v"(a),"v"(b));return r;}
__device__ __forceinline__ float fadd_s(float a,float b){float r;asm("v_add_f32_e32 %0, %1, %2":"=v"(r):"v"(a),"v"(b));return r;}
__device__ __forceinline__ float fsub_s(float a,float b){float r;asm("v_sub_f32_e32 %0, %1, %2":"=v"(r):"v"(a),"v"(b));return r;}
typedef float f32x2_t __attribute__((ext_vector_type(2))); typedef __bf16 bf16x2_t __attribute__((ext_vector_type(2)));
__device__ __forceinline__ unsigned cvtpk_s(float lo,float hi){f32x2_t v={lo,hi};bf16x2_t b=__builtin_convertvector(v,bf16x2_t);return __builtin_bit_cast(unsigned,b);}
#define WAIT_BAR(N) asm volatile("s_waitcnt vmcnt(" #N ") lgkmcnt(0)\n\ts_barrier":::"memory")

__device__ __forceinline__ void qkt(f32x16&p0,f32x16&p1,const char*Kslot,const bf16x8*qr,const f32x16&negm,int r32,int hi){
  const char*kb=Kslot+hi*1024+r32*16;
  #pragma unroll
  for(int d0=0;d0<4;++d0){
    const bf16x8 b0=*reinterpret_cast<const bf16x8*>(kb+d0*2048);
    const bf16x8 b1=*reinterpret_cast<const bf16x8*>(kb+d0*2048+512);
    if(d0==0){p0=__builtin_amdgcn_mfma_f32_32x32x16_bf16(b0,qr[0],negm,0,0,0);p1=__builtin_amdgcn_mfma_f32_32x32x16_bf16(b1,qr[0],negm,0,0,0);}
    else{p0=__builtin_amdgcn_mfma_f32_32x32x16_bf16(b0,qr[d0],p0,0,0,0);p1=__builtin_amdgcn_mfma_f32_32x32x16_bf16(b1,qr[d0],p1,0,0,0);}}
}
typedef __attribute__((address_space(3))) const char* lds_cptr;
typedef short v4i16_t __attribute__((ext_vector_type(4)));
__device__ __forceinline__ void kload8(bf16x8*kf,lds_cptr kp){
  kf[0]=*(const __attribute__((address_space(3))) bf16x8*)(kp);      kf[1]=*(const __attribute__((address_space(3))) bf16x8*)(kp+512);
  kf[2]=*(const __attribute__((address_space(3))) bf16x8*)(kp+2048); kf[3]=*(const __attribute__((address_space(3))) bf16x8*)(kp+2560);
  kf[4]=*(const __attribute__((address_space(3))) bf16x8*)(kp+4096); kf[5]=*(const __attribute__((address_space(3))) bf16x8*)(kp+4608);
  kf[6]=*(const __attribute__((address_space(3))) bf16x8*)(kp+6144); kf[7]=*(const __attribute__((address_space(3))) bf16x8*)(kp+6656);
}
__device__ __forceinline__ void kload2(bf16x8*kf,lds_cptr kp,int j){ kf[2*j]=*(const __attribute__((address_space(3))) bf16x8*)(kp+j*2048); kf[2*j+1]=*(const __attribute__((address_space(3))) bf16x8*)(kp+j*2048+512); }
__device__ __forceinline__ s16x4 vtr(lds_cptr p){ return __builtin_bit_cast(s16x4,__builtin_amdgcn_ds_read_tr16_b64_v4i16((__attribute__((address_space(3))) v4i16_t*)p)); }
__device__ __forceinline__ float rowmax(const f32x16&p0,const f32x16&p1){
  float a=max3f(p0[0],p0[1],p1[0]),b=max3f(p0[2],p0[3],p1[1]);a=max3f(a,p1[2],p1[3]);
  #pragma unroll
  for(int r=4;r<16;r+=4){a=max3f(a,p0[r],p0[r+1]);b=max3f(b,p0[r+2],p0[r+3]);a=max3f(a,p1[r],p1[r+1]);b=max3f(b,p1[r+2],p1[r+3]);}
  const float m=max2f(a,b);
  auto rr=__builtin_amdgcn_permlane32_swap(__float_as_uint(m),__float_as_uint(m),false,false);
  return max2f(__uint_as_float(rr[0]),__uint_as_float(rr[1]));
}
__device__ __forceinline__ void pv(f32x16*o,int vb,bf16x8 pa0,bf16x8 pa1,bf16x8 pa2,bf16x8 pa3){
  #pragma unroll
  for(int d0=0;d0<2;++d0){s16x4 lo[4],hi[4];
    #pragma unroll
    for(int ks=0;ks<4;++ks){
      asm volatile("ds_read_b64_tr_b16 %0,%1 offset:%c2":"=&v"(lo[ks]):"v"(vb),"i"(d0*4096+ks*1024):"memory");
      asm volatile("ds_read_b64_tr_b16 %0,%1 offset:%c2":"=&v"(hi[ks]):"v"(vb),"i"(d0*4096+ks*1024+512):"memory");}
    asm volatile("s_waitcnt lgkmcnt(0)":::"memory");SBAR();
    #define PK(k) (bf16x8){lo[k][0],lo[k][1],lo[k][2],lo[k][3],hi[k][0],hi[k][1],hi[k][2],hi[k][3]}
    o[d0]=__builtin_amdgcn_mfma_f32_32x32x16_bf16(pa0,PK(0),o[d0],0,0,0);
    o[d0]=__builtin_amdgcn_mfma_f32_32x32x16_bf16(pa1,PK(1),o[d0],0,0,0);
    o[d0]=__builtin_amdgcn_mfma_f32_32x32x16_bf16(pa2,PK(2),o[d0],0,0,0);
    o[d0]=__builtin_amdgcn_mfma_f32_32x32x16_bf16(pa3,PK(3),o[d0],0,0,0);
    #undef PK
  }
}

#ifndef ATTN_STORE16
#define ATTN_STORE16(p,v) (*(u32x4*)(p)=(v))
#endif
template<int THRL> __device__ __forceinline__ void attn_unit(int b,int h,int qb,const bf16*Q,const bf16*__restrict__ K,const bf16*__restrict__ V,bf16*O,float*ssq,char*shm){
  const int tid=threadIdx.x,lane=tid&63,r32=lane&31,hi=lane>>5; const int wid=__builtin_amdgcn_readfirstlane(tid>>6);
  const long rowbase=(long)b*SEQ; const int q0=qb*QB;
  const bf16*Qw=Q+(rowbase+q0+wid*QBLK)*QP+h*D; const int kvh=h>>2;
  const bf16*Kh=K+rowbase*KP+kvh*D,*Vh=V+rowbase*KP+kvh*D;
  const unsigned lds0=(unsigned)(uintptr_t)shm;
  float*wsf=(float*)(shm+LDS_WS)+wid*64;
  const bf16*ksrc=Kh+(long)lane*KP+wid*8;
  const bf16*vsrc=Vh+(long)(16*(wid&3)+(lane>>2))*KP+(wid>>2)*32+(lane&3)*8;
  const unsigned kdst=lds0+LDS_K+wid*1024, vdst=lds0+LDS_V+wid*1024;
  #define DMA_K(t,slot) glds16(ksrc+(long)(t)*KVBLK*KP,(unsigned)__builtin_amdgcn_readfirstlane(kdst+(slot)))
  #define DMA_V(t,slot) glds16(vsrc+(long)(t)*KVBLK*KP,(unsigned)__builtin_amdgcn_readfirstlane(vdst+(slot)))
  const int vb0=(int)(lds0+LDS_V)+((lane>>4)&1)*32+(lane&3)*8+(4*hi+((lane&15)>>2))*64;
  const char*Kbase=shm+LDS_K; bf16x8 kf[8];
  const lds_cptr shm3=(lds_cptr)shm; const lds_cptr kp0=shm3+LDS_K+hi*1024+r32*16; const lds_cptr vp0=shm3+LDS_V+((lane>>4)&1)*32+(lane&3)*8+(4*hi+((lane&15)>>2))*64;
  const int NT=SEQ/KVBLK;
  DMA_K(0,0);DMA_V(0,0);DMA_K(1,SLOTB);
  bf16x8 qr[4];
  #pragma unroll
  for(int d0=0;d0<4;++d0)qr[d0]=*reinterpret_cast<const bf16x8*>(&Qw[(long)r32*QP+d0*16+hi*8]);
  float mhat=0.f,l_reg=0.f;f32x16 o[2];o[0]=f32x16{};o[1]=f32x16{};f32x16 negm=f32x16{};asm volatile("":"+v"(negm));

  #define CMASK(P0,P1,t) do{}while(0)
  bool resc=false;
  #define START(P0,P1) do{ const float rm=rowmax(P0,P1); resc=false; \
    { const float dl=rm; mhat=fadd_s(mhat,dl); \
      _Pragma("unroll") for(int r=0;r<16;++r){P0[r]=fsub_s(P0[r],dl);P1[r]=fsub_s(P1[r],dl);} \
      _Pragma("unroll") for(int r=0;r<16;++r)negm[r]=-mhat; asm volatile("":"+v"(negm)); } \
    _Pragma("unroll") for(int r=0;r<16;++r)P0[r]=__builtin_amdgcn_exp2f(P0[r]); }while(0)
  #define RESC() do{ if(resc){ asm volatile("s_waitcnt lgkmcnt(0)":::"memory"); \
      _Pragma("unroll") for(int d_=0;d_<2;++d_) _Pragma("unroll") for(int r=0;r<16;++r)o[d_][r]*=wsf[crow(r,hi)]; } }while(0)
  f32x16 pA0,pA1,pB0,pB1;
  int sl_prev=0,sl_cur=0,sl_next=SLOTB;
  #define ROT() do{sl_prev=sl_cur;sl_cur=sl_next;sl_next=(sl_next==(NSLOT-1)*SLOTB)?0:sl_next+SLOTB;}while(0)
  DMA_K(2,2*SLOTB);
  WAIT_BAR(3);
  qkt(pA0,pA1,Kbase,qr,negm,r32,hi);asm volatile("s_nop 15\n\ts_nop 7":"+v"(pA0),"+v"(pA1));CMASK(pA0,pA1,0);
  START(pA0,pA1);
  _Pragma("unroll") for(int r=0;r<16;++r)pA1[r]=__builtin_amdgcn_exp2f(pA1[r]);
  WAIT_BAR(0);
  DMA_K(3,0);DMA_V(1,SLOTB);
  ROT();
  kload8(kf,kp0+sl_cur);
  WAIT_BAR(2);
  s16x4 vlo[8],vhi[8]; u32x4 pw0,pw1,pw2,pw3;
  #define PKW(P,B) cvtpk_s(P[B],P[B+1])
  #define PAF(k) __builtin_bit_cast(bf16x8,pw##k)
  #define VFR(i) (bf16x8){vlo[i][0],vlo[i][1],vlo[i][2],vlo[i][3],vhi[i][0],vhi[i][1],vhi[i][2],vhi[i][3]}
  #define PIN(x) asm volatile("":"+v"(x))
  #define MX3(a,b,c) __builtin_fmaxf(__builtin_fmaxf((a),(b)),(c))
  #define GAPA(MF,A0,A1,A2,A3,W0,W1,PW) do{ MF; sacc+=A0; sacc+=A1; sacc+=A2; sacc+=A3; PIN(sacc); W0; W1; PIN(PW); SBAR(); }while(0)
  #define EX(v) __builtin_amdgcn_exp2f(v)
  #define GAPB(MF,X,B) do{ MF; X[B]=EX(X[B]); X[B+1]=EX(X[B+1]); X[B+2]=EX(X[B+2]); X[B+3]=EX(X[B+3]); PIN(X); SBAR(); }while(0)
  #define VRD(i) do{ vlo[i]=vtr(vp_+(((i)>>2)*4096+((i)&3)*1024)); vhi[i]=vtr(vp_+(((i)>>2)*4096+((i)&3)*1024+512)); }while(0)
  #define KRD(G,j) do{ if(G){ kload2(kf,kp0+sl_next,j); SBAR(); } }while(0)
  #define STEP(C0,C1,P0,P1,t,GK,GV,GL) do{ SBAR(); \
    const lds_cptr vp_=vp0+sl_prev; \
    VRD(0); SBAR(); float sacc=(P0[0]+P0[1]); \
    GAPA(C0=__builtin_amdgcn_mfma_f32_32x32x16_bf16(kf[0],qr[0],negm,0,0,0), P0[2],P0[3],P0[4],P0[5],     pw0[0]=PKW(P0,0), pw0[1]=PKW(P0,2), pw0); \
    VRD(4); SBAR(); GAPA(C1=__builtin_amdgcn_mfma_f32_32x32x16_bf16(kf[1],qr[0],negm,0,0,0), P0[6],P0[7],P0[8],P0[9],     pw0[2]=PKW(P0,4), pw0[3]=PKW(P0,6), pw0); \
    VRD(1); SBAR(); GAPA(C0=__builtin_amdgcn_mfma_f32_32x32x16_bf16(kf[2],qr[1],C0,0,0,0),   P0[10],P0[11],P0[12],P0[13], pw1[0]=PKW(P0,8), pw1[1]=PKW(P0,10), pw1); \
    VRD(5); SBAR(); GAPA(C1=__builtin_amdgcn_mfma_f32_32x32x16_bf16(kf[3],qr[1],C1,0,0,0),   P0[14],P0[15],P1[0],P1[1],   pw1[2]=PKW(P0,12),pw1[3]=PKW(P0,14), pw1); \
    VRD(2); SBAR(); GAPA(C0=__builtin_amdgcn_mfma_f32_32x32x16_bf16(kf[4],qr[2],C0,0,0,0),   P1[2],P1[3],P1[4],P1[5],     pw2[0]=PKW(P1,0), pw2[1]=PKW(P1,2), pw2); \
    VRD(6); SBAR(); GAPA(C1=__builtin_amdgcn_mfma_f32_32x32x16_bf16(kf[5],qr[2],C1,0,0,0),   P1[6],P1[7],P1[8],P1[9],     pw2[2]=PKW(P1,4), pw2[3]=PKW(P1,6), pw2); \
    VRD(3); SBAR(); GAPA(C0=__builtin_amdgcn_mfma_f32_32x32x16_bf16(kf[6],qr[3],C0,0,0,0),   P1[10],P1[11],P1[12],P1[13], pw3[0]=PKW(P1,8), pw3[1]=PKW(P1,10), pw3); \
    VRD(7); SBAR(); GAPA(C1=__builtin_amdgcn_mfma_f32_32x32x16_bf16(kf[7],qr[3],C1,0,0,0),   P1[14],P1[15],0.f,0.f,       pw3[2]=PKW(P1,12),pw3[3]=PKW(P1,14), pw3); \
    l_reg+=sacc; \
    if(GK){DMA_K((t)+3,sl_cur);} if(GV){DMA_V((t)+1,sl_next);} \
    CMASK(C0,C1,t); \
    { float a=MX3(C0[0],C0[1],C1[0]),b=MX3(C0[2],C0[3],C1[1]); a=MX3(a,C1[2],C1[3]); \
      _Pragma("unroll") for(int r=4;r<16;r+=4){a=MX3(a,C0[r],C0[r+1]);b=MX3(b,C0[r+2],C0[r+3]);a=MX3(a,C1[r],C1[r+1]);b=MX3(b,C1[r+2],C1[r+3]);} \
      float rm=__builtin_fmaxf(a,b); { auto rr=__builtin_amdgcn_permlane32_swap(__float_as_uint(rm),__float_as_uint(rm),false,false); rm=__builtin_fmaxf(__uint_as_float(rr[0]),__uint_as_float(rr[1])); } \
      resc=false; \
      if(__builtin_expect(__any(rm>(float)THRL),0)){ const float dl=__builtin_fmaxf(rm,0.f); mhat+=dl; \
        _Pragma("unroll") for(int r=0;r<16;++r){C0[r]-=dl;C1[r]-=dl;} \
        _Pragma("unroll") for(int r=0;r<16;++r)negm[r]=-mhat; asm volatile("":"+v"(negm)); \
        const float f=__builtin_amdgcn_exp2f(-dl); l_reg*=f; if(hi==0)wsf[r32]=f; resc=true; } } \
    SBAR(); \
    GAPB(o[0]=__builtin_amdgcn_mfma_f32_32x32x16_bf16(PAF(0),VFR(0),o[0],0,0,0), C0,0); \
    GAPB(o[1]=__builtin_amdgcn_mfma_f32_32x32x16_bf16(PAF(0),VFR(4),o[1],0,0,0), C0,4); \
    KRD(GL,0); GAPB(o[0]=__builtin_amdgcn_mfma_f32_32x32x16_bf16(PAF(1),VFR(1),o[0],0,0,0), C0,8); \
    KRD(GL,1); GAPB(o[1]=__builtin_amdgcn_mfma_f32_32x32x16_bf16(PAF(1),VFR(5),o[1],0,0,0), C0,12); \
    KRD(GL,2); GAPB(o[0]=__builtin_amdgcn_mfma_f32_32x32x16_bf16(PAF(2),VFR(2),o[0],0,0,0), C1,0); \
    KRD(GL,3); GAPB(o[1]=__builtin_amdgcn_mfma_f32_32x32x16_bf16(PAF(2),VFR(6),o[1],0,0,0), C1,4); \
    GAPB(o[0]=__builtin_amdgcn_mfma_f32_32x32x16_bf16(PAF(3),VFR(3),o[0],0,0,0), C1,8); \
    GAPB(o[1]=__builtin_amdgcn_mfma_f32_32x32x16_bf16(PAF(3),VFR(7),o[1],0,0,0), C1,12); \
    }while(0)
  int t=1;
  #undef CMASK
  #define CMASK(P0,P1,t) do{}while(0)
  for(;t+5<NT;t+=2){
    STEP(pB0,pB1,pA0,pA1,t,true,true,true);     WAIT_BAR(2); RESC(); ROT();
    STEP(pA0,pA1,pB0,pB1,t+1,true,true,true);   WAIT_BAR(2); RESC(); ROT();
  }
  #undef CMASK
  #define CMASK(P0,P1,t) do{}while(0)
  #define ENDW(tt) do{ if((tt)+3<NT){WAIT_BAR(2);} else if((tt)+2<NT){WAIT_BAR(1);} else {WAIT_BAR(0);} }while(0)
  for(;t+1<NT;t+=2){
    STEP(pB0,pB1,pA0,pA1,t,(t+3<NT),(t+1<NT),(t+1<NT));       ENDW(t);   RESC(); ROT();
    STEP(pA0,pA1,pB0,pB1,t+1,(t+4<NT),(t+2<NT),(t+2<NT));     ENDW(t+1); RESC(); ROT();
  }
  STEP(pB0,pB1,pA0,pA1,NT-1,false,false,false); RESC();
  { float sacc=pB0[0]+pB0[1]; _Pragma("unroll") for(int r=2;r<16;++r)sacc+=pB0[r]; _Pragma("unroll") for(int r=0;r<16;++r)sacc+=pB1[r]; l_reg+=sacc;
    pw0=(u32x4){PKW(pB0,0),PKW(pB0,2),PKW(pB0,4),PKW(pB0,6)};pw1=(u32x4){PKW(pB0,8),PKW(pB0,10),PKW(pB0,12),PKW(pB0,14)};pw2=(u32x4){PKW(pB1,0),PKW(pB1,2),PKW(pB1,4),PKW(pB1,6)};pw3=(u32x4){PKW(pB1,8),PKW(pB1,10),PKW(pB1,12),PKW(pB1,14)};
    SBAR(); pv(o,vb0+sl_cur,PAF(0),PAF(1),PAF(2),PAF(3)); }
  #undef PKW
  #undef PAF
  #undef VFR
  #undef PIN
  #undef MX3
  #undef GAPA
  #undef GAPB
  #undef EX
  #undef VRD
  #undef KRD
  #undef STEP
  #undef ENDW
  {auto rr=__builtin_amdgcn_permlane32_swap(__float_as_uint(l_reg),__float_as_uint(l_reg),false,false);l_reg=__uint_as_float(rr[0])+__uint_as_float(rr[1]);}
  if(hi==0)wsf[32+r32]=l_reg;asm volatile("s_waitcnt lgkmcnt(0)":::"memory");
  float rli[16];
  #pragma unroll
  for(int r=0;r<16;++r)rli[r]=__builtin_amdgcn_rcpf(wsf[32+crow(r,hi)]);
  bf16*Ow=O+(rowbase+q0+wid*QBLK)*OP+h*D; float*ssw=ssq+rowbase+q0+wid*QBLK;
  { bf16*stg=(bf16*)(shm+LDS_OST)+wid*2048;
    #pragma unroll
    for(int r=0;r<16;++r){const int orow=crow(r,hi);
      #pragma unroll
      for(int d0=0;d0<2;++d0)stg[orow*64+d0*32+r32]=__float2bfloat16(o[d0][r]*rli[r]);}
    asm volatile("s_waitcnt lgkmcnt(0)":::"memory");
    #pragma unroll
    for(int i=0;i<4;++i){const int row=i*8+(lane>>3),ch=lane&7; const u32x4 v=*(const u32x4*)(stg+row*64+ch*8); ATTN_STORE16(Ow+(long)row*OP+ch*8,v);
      float sq=0.f; _Pragma("unroll") for(int e=0;e<4;++e){const float a=__uint_as_float(v[e]<<16),c=__uint_as_float(v[e]&0xffff0000u); sq+=a*a+c*c;}
      sq+=__shfl_xor(sq,1); sq+=__shfl_xor(sq,2); sq+=__shfl_xor(sq,4); if(ch==0)atomicAdd(ssw+row,sq);} }
  asm volatile("s_waitcnt lgkmcnt(0)\n\ts_barrier":::"memory");
  #undef DMA_K
  #undef DMA_V
  #undef CMASK
  #undef START
  #undef RESC
  #undef ROT
}
constexpr int ATTN_LDS_BYTES=LDS_BYTES;
struct AttnTensors { const bf16* Q; const bf16* K; const bf16* V; bf16* O; float* ssq; };
struct AttnUnit { int bh; int qb; };
struct StaticOrder {
  int vcu, G;
  __device__ __forceinline__ explicit StaticOrder(int grid,int block):vcu((grid%8==0)?(block%8)*(grid/8)+block/8:block),G(grid){}
  __device__ __forceinline__ bool next(int i,AttnUnit&u)const{ const int n=vcu+i*G; if(n>=BATCH*NHEAD*NQB)return false; u.bh=n>>5; u.qb=n&31; return true; }
  __device__ __forceinline__ void a_ready(const AttnUnit&)const{}
  __device__ __forceinline__ void done(const AttnUnit&)const{}
};
template<class Sched,int THRL=8> __device__ __forceinline__ void attn_phase(char*lds,const AttnTensors&T,const Sched&S){
  AttnUnit u;
  for(int i=0;S.next(i,u);++i){ S.a_ready(u); attn_unit<THRL>(u.bh/NHEAD,u.bh%NHEAD,u.qb,T.Q,T.K,T.V,T.O,T.ssq,lds); S.done(u); }
}
#undef SBAR
#undef WAIT_BAR
}
#define XB_TMO      128
#define XB_XCNT(j)  (256  + 64 * (j))
#define XB_XSUB(j)  (1280 + 64 * (j))
#define XB_XGEN(j)  (2304 + 64 * (j))
#define XB_TOP      3328
#define XB_TOPGEN   3392
#define XCD_BAR_WORDS 3456
#define XB_SPIN_CAP (1u << 18)

__device__ __forceinline__ unsigned xb_ld(unsigned* p)              { return __hip_atomic_load(p, __ATOMIC_RELAXED, __HIP_MEMORY_SCOPE_AGENT); }
__device__ __forceinline__ unsigned xb_add(unsigned* p, unsigned v) { return __hip_atomic_fetch_add(p, v, __ATOMIC_RELAXED, __HIP_MEMORY_SCOPE_AGENT); }
__device__ __forceinline__ unsigned xb_xcc_id() { return (unsigned)__builtin_amdgcn_s_getreg((3 << 11) | 20) & 0xFu; }
#define XB_SPIN(cond, bar) do { unsigned _sp = 0; while (cond) { __builtin_amdgcn_s_sleep(1); \
    if ((++_sp & 255u) == 0u) { if (xb_ld(&(bar)[XB_TMO])) break; if (_sp > XB_SPIN_CAP) { atomicAdd(&(bar)[XB_TMO], 1u); break; } } } } while (0)

struct XcdBarrier {
    unsigned* bar; unsigned x;
    volatile LAS unsigned* st;
};

__device__ __forceinline__ XcdBarrier xcd_barrier_post(unsigned* bar, volatile LAS unsigned* st) {
    XcdBarrier b; b.bar = bar; b.x = xb_xcc_id(); b.st = st;
    if (threadIdx.x == 0) (void)xb_add(&bar[XB_XCNT(b.x)], 1u);
    return b;
}
__device__ __forceinline__ void xcd_barrier_complete(unsigned* bar, unsigned x, unsigned& nloc, unsigned& nx) {
    const unsigned G = gridDim.x * gridDim.y * gridDim.z;
    unsigned sum, cnt, mine, sp = 0u;
    for (;;) {
        sum = 0u; cnt = 0u; mine = 0u;
#pragma unroll
        for (unsigned j = 0; j < 16; ++j) { const unsigned c = xb_ld(&bar[XB_XCNT(j)]); sum += c; cnt += (c > 0u) ? 1u : 0u; mine = (j == x) ? c : mine; }
        if (sum == G) break;
        __builtin_amdgcn_s_sleep(1);
        if ((++sp & 255u) == 0u) { if (xb_ld(&bar[XB_TMO])) break; if (sp > XB_SPIN_CAP) { atomicAdd(&bar[XB_TMO], 1u); break; } }
    }
    nloc = mine > 0u ? mine : 1u; nx = cnt > 0u ? cnt : 1u;
}

__device__ __forceinline__ void xcd_barrier(const XcdBarrier& b) {
    asm volatile("s_waitcnt vmcnt(0)" ::: "memory");
    __syncthreads();
    if (threadIdx.x == 0) {
        unsigned* bar = b.bar;
        __builtin_amdgcn_s_waitcnt(0);
        unsigned nloc = b.st[0], nx = b.st[1];
        if (nloc == 0u) { xcd_barrier_complete(bar, b.x, nloc, nx); b.st[0] = nloc; b.st[1] = nx; }
        const unsigned old = xb_add(&bar[XB_XSUB(b.x)], 1u);
        const unsigned gen = old / nloc;
        if (old + 1u == (gen + 1u) * nloc) {
            __builtin_amdgcn_fence(__ATOMIC_RELEASE, "agent");
            asm volatile("s_waitcnt vmcnt(0)" ::: "memory");
            const unsigned og = xb_add(&bar[XB_TOP], 1u);
            const unsigned tg = og / nx;
            if (og + 1u == (tg + 1u) * nx) xb_add(&bar[XB_TOPGEN], 1u);
            else XB_SPIN(xb_ld(&bar[XB_TOPGEN]) == tg, bar);
            __builtin_amdgcn_fence(__ATOMIC_ACQUIRE, "agent");
            xb_add(&bar[XB_XGEN(b.x)], 1u);
            asm volatile("s_waitcnt vmcnt(0)" ::: "memory");
        } else {
            XB_SPIN(xb_ld(&bar[XB_XGEN(b.x)]) == gen, bar);
            __builtin_amdgcn_fence(__ATOMIC_ACQUIRE, "agent");
            asm volatile("s_waitcnt vmcnt(0)" ::: "memory");
        }
    }
    __syncthreads();
}

__global__ void __launch_bounds__(NTHREADS, 2) fwd_kernel(Params p) {
    extern __shared__ __attribute__((aligned(16))) unsigned char lds_raw[];
    LAS unsigned char* lds = (LAS unsigned char*)lds_raw;
    cg::grid_group grid = cg::this_grid();
    const int bid = blockIdx.x, nb = gridDim.x, tid = threadIdx.x, lane = tid & 63, wave = tid >> 6;
    const int lo = p.ph_lo, hi = p.ph_hi;
#define IN(k) (lo <= (k) && (k) < hi)
#define SEAM(k) do { if (IN(k) && IN((k) + 1)) { if (p.use_cg) grid.sync(); else xcd_barrier(xbar); } } while (0)
    volatile LAS unsigned* MISC = (volatile LAS unsigned*)(lds + LDS_BYTES - 128);
    if (tid < 32) MISC[tid] = 0u;
    __syncthreads();
    XcdBarrier xbar = xcd_barrier_post((unsigned*)(p.ws + WS_CTL), MISC + 8);
    unsigned char* ws = p.ws;
    float* ssatt = (float*)(ws + WS_CTL + CTL_SSATT); float* ss2 = (float*)(ws + WS_CTL + CTL_SS2); float* ss3 = (float*)(ws + WS_CTL + CTL_SS3); const float* LB = (const float*)(ws + WS_CTL + CTL_LB);

    if (IN(0)) { p0_prologue(p, lds, bid, nb); } SEAM(0);
    if (IN(1)) { pg8::PgEpiIn E{(bf16_t*)(ws + WS_QH), (float*)(ws + WS_ZF), (bf16_t*)(ws + WS_IV), (bf16_t*)(ws + WS_GH), (float*)(ws + WS_AQKV), LB};
        pg8::Gemm g{(const bf16_t*)(ws + WS_XN), (const bf16_t*)(ws + WS_WIN), M, DIN, D}; pg8::StaticOrder S; S.init(M, DIN, nb, bid);
        pg8::gemm_phase<pg8::PgEpiIn, pg8::StaticOrder, true, true>(lds, g, S, E);
        if (PROBE_DUP & 8) pg8::gemm_phase<pg8::PgEpiIn, pg8::StaticOrder, true, true>(lds, g, S, E); } SEAM(1);
    if (IN(2)) { for (int rep = 0; rep < ((PROBE_DUP & 1) ? 2 : 1); ++rep) { p2_qkconvert(p, bid, nb);
        for (int u = bid; u < 512; u += nb) { const int dir = u >> 8, b = (u >> 7) & 1, h = (u >> 5) & 3, sc = u & 31; if (dir == 0) hg::pass1_unit<0>(p, lds, b, h, sc); else hg::pass1_unit<1>(p, lds, b, h, sc); } }
    } SEAM(2);
    if (IN(3)) { hg::scan_phase(p, bid, nb); if (PROBE_DUP & 32) { for (int i = 0; i < 16; ++i) grid.sync(); } } SEAM(3);
    if (IN(4)) {
        for (int rep = 0; rep < ((PROBE_DUP & 2) ? 2 : 1); ++rep)
        for (int u = bid; u < 256; u += nb) hg::pass2_unit(p, lds, u >> 7, (u >> 5) & 3, u & 31);
        { const attn_body::AttnTensors AT{(const attn_body::bf16*)(ws + WS_QA), (const attn_body::bf16*)(ws + WS_KA), (const attn_body::bf16*)(ws + WS_VA), (attn_body::bf16*)(ws + WS_MIX), ssatt};
          const attn_body::StaticOrder SO(nb, bid);
          attn_body::attn_phase<attn_body::StaticOrder>((char*)lds_raw, AT, SO);
          if (PROBE_DUP & 4) { const attn_body::AttnTensors AT2{AT.Q, AT.K, AT.V, AT.O, (float*)(ws + WS_CTL + 320 * 1024)}; attn_body::attn_phase<attn_body::StaticOrder>((char*)lds_raw, AT2, SO); } }
    } SEAM(4);
    if (IN(5)) { pg8::PgEpiOut E{p.x, p.out, (bf16_t*)(ws + WS_XB), ss2, ssatt};
        pg8::Gemm g{(const bf16_t*)(ws + WS_MIX), (const bf16_t*)(ws + WS_WOUT), M, D, D}; pg8::StaticOrder S; S.init(M, D, nb, bid);
        pg8::gemm_phase<pg8::PgEpiOut, pg8::StaticOrder, true, true>(lds, g, S, E); } SEAM(5);
    if (IN(6)) { pg8::PgEpiGU E{(bf16_t*)(ws + WS_H), ss2};
        pg8::Gemm g{(const bf16_t*)(ws + WS_XB), (const bf16_t*)(ws + WS_WGU), M, 2 * DFF, D}; pg8::StaticOrder S; S.init(M, 2 * DFF, nb, bid);
        pg8::gemm_phase<pg8::PgEpiGU, pg8::StaticOrder, true, true>(lds, g, S, E);
        if (PROBE_DUP & 16) pg8::gemm_phase<pg8::PgEpiGU, pg8::StaticOrder, true, true>(lds, g, S, E); } SEAM(6);
    if (IN(7)) { pg8::PgEpiDown E{p.out, ss3};
        pg8::Gemm g{(const bf16_t*)(ws + WS_H), (const bf16_t*)(ws + WS_WDN), M, D, DFF}; pg8::StaticOrder S; S.init(M, D, nb, bid);
        pg8::gemm_phase<pg8::PgEpiDown, pg8::StaticOrder, true, true>(lds, g, S, E); } SEAM(7);
    if (IN(8)) {
        const int gw = bid * NWAVES + wave, NGW = nb * NWAVES;
        for (int m = gw; m < M; m += NGW) { f32x4* xr = (f32x4*)(p.out + (size_t)m * D) + lane; const f32x4* wr = (const f32x4*)p.final_norm_w + lane;
            const float rstd = 1.f / sqrtf(ss3[m] * (1.f / D) + EPS);
#pragma unroll
            for (int j = 0; j < 4; ++j) { f32x4 v = xr[64 * j]; const f32x4 w = wr[64 * j]; v.x *= rstd * w.x; v.y *= rstd * w.y; v.z *= rstd * w.z; v.w *= rstd * w.w; xr[64 * j] = v; } }
    }
#undef IN
#undef SEAM
}

extern "C" void kernel_launch(void* const* d_in, const int* in_sizes, int n_in, void* d_out, int out_size, void* d_ws, size_t ws_size, hipStream_t stream) {
    static int grid = 0;
    if (grid == 0) {
        if (n_in != 13 || in_sizes[0] != M * D || out_size != M * D || ws_size < WS_END) { fprintf(stderr, "kernel_launch: unexpected shapes (n_in %d, in0 %d, out %d, ws %zu)\n", n_in, n_in > 0 ? in_sizes[0] : -1, out_size, ws_size); grid = -1; return; }
        int dev = 0, cus = 0, per_cu = 0;
        hipGetDevice(&dev); hipDeviceGetAttribute(&cus, hipDeviceAttributeMultiprocessorCount, dev);
        if (hipFuncSetAttribute((const void*)fwd_kernel, hipFuncAttributeMaxDynamicSharedMemorySize, LDS_BYTES) != hipSuccess) { fprintf(stderr, "kernel_launch: hipFuncSetAttribute failed\n"); grid = -1; return; }
        if (hipOccupancyMaxActiveBlocksPerMultiprocessor(&per_cu, (const void*)fwd_kernel, NTHREADS, LDS_BYTES) != hipSuccess || per_cu < 1) { fprintf(stderr, "kernel_launch: occupancy query says %d\n", per_cu); per_cu = 1; }
        (void)hipGetLastError();
        grid = cus;
    }
    if (grid < 0) return;
    hipMemsetAsync((char*)d_ws + WS_CTL, 0, CTL_ZERO_BYTES, stream);
    Params p{};
    p.x = (const float*)d_in[0]; p.norm1_w = (const float*)d_in[1]; p.w_in = (const float*)d_in[2]; p.lb_logits = (const float*)d_in[3]; p.hg_norm_w = (const float*)d_in[4];
    p.q_norm_w = (const float*)d_in[5]; p.k_norm_w = (const float*)d_in[6]; p.att_norm_w = (const float*)d_in[7]; p.w_out = (const float*)d_in[8]; p.norm2_w = (const float*)d_in[9];
    p.w_gate_up = (const float*)d_in[10]; p.w_down = (const float*)d_in[11]; p.final_norm_w = (const float*)d_in[12];
    p.out = (float*)d_out; p.ws = (unsigned char*)d_ws;
#if MK_N_LAUNCHES == 1
    p.ph_lo = 0; p.ph_hi = NPH;
    void* args[] = {&p};
    hipError_t e = hipLaunchCooperativeKernel((const void*)fwd_kernel, dim3(grid), dim3(NTHREADS), args, LDS_BYTES, stream);
    if (e != hipSuccess) fprintf(stderr, "cooperative launch failed: %s (grid %d)\n", hipGetErrorString(e), grid);
#else
    for (int ph = 0; ph < NPH; ++ph) { p.ph_lo = ph; p.ph_hi = ph + 1; hipLaunchKernelGGL(fwd_kernel, dim3(grid), dim3(NTHREADS), LDS_BYTES, stream, p); }
#endif
}
```
